# Optimizing an MI355X kernel written in HIP

```python
import jax, jax.numpy as jnp
from jax import lax
import numpy as np

D_MODEL = 2048
BATCH = 4
SEQ = 4096
DEPTH = 4
DEC_BATCH = 16
DEC_SEQ = 32
PAST_LEN = 2048

CHUNK = 64
N_MIXERS = 2
N_HEADS = 16
HEAD_DIM = D_MODEL // N_HEADS
N_ATTN = (DEPTH + 1) // 2
N_HGRN = DEPTH // 2
Q_BLOCK = 128
SUB_CHUNK = 16
N_PROJ = 4
EPS = 1e-6
LB_FLOOR = 1e-30

kernel_name = 'stickbreak_hgrn2_streaming_step'


def rms_norm(x, w):
    xf = x.astype(jnp.float32)
    y = xf * lax.rsqrt(jnp.mean(xf * xf, axis=-1, keepdims=True) + EPS)
    return (y * w.astype(jnp.float32)).astype(x.dtype)


def stick_breaking_block(q, k, v, q_pos, k_pos):
    z = jnp.einsum('bqhd,bkhd->bhqk', q, k).astype(jnp.float32) * (HEAD_DIM ** -0.5)
    earlier = k_pos[None, :] < q_pos[:, None]
    log_one_minus = jnp.where(earlier, jax.nn.log_sigmoid(-z), 0.0)
    between = lax.cumsum(log_one_minus, axis=3, reverse=True) - log_one_minus
    w = jnp.where(earlier, jnp.exp(jnp.where(earlier, jax.nn.log_sigmoid(z) + between, 0.0)), 0.0)
    return jnp.einsum('bhqk,bkhd->bqhd', w.astype(v.dtype), v)


def stick_breaking(q, k, v, q_offset):
    tq = q.shape[1]
    outs = []
    for start in range(0, tq, Q_BLOCK):
        end = min(start + Q_BLOCK, tq)
        kend = q_offset + end
        outs.append(stick_breaking_block(q[:, start:end], k[:, :kend], v[:, :kend],
                                         jnp.arange(q_offset + start, q_offset + end), jnp.arange(kend)))
    return jnp.concatenate(outs, axis=1)


def hgrn2_chunk(S, inp):
    q, k, v, g = inp
    bn, h, c, dk = q.shape
    n = c // SUB_CHUNK
    b = jnp.cumsum(g, axis=2)
    o = jnp.einsum('bhtk,bhkv->bhtv', q * jnp.exp(b), S)
    qs = q.reshape(bn, h, n, SUB_CHUNK, dk)
    ks = k.reshape(bn, h, n, SUB_CHUNK, dk)
    bs = b.reshape(bn, h, n, SUB_CHUNK, dk)
    b_ref = jnp.concatenate([jnp.zeros_like(bs[:, :, :1, 0]), bs[:, :, :-1, -1]], axis=2)
    q_rel = qs * jnp.exp(jnp.minimum(bs - b_ref[:, :, :, None], 0.0))
    k_rel = ks[:, :, None] * jnp.exp(jnp.minimum(b_ref[:, :, :, None, None] - bs[:, :, None], 0.0))
    sub = jnp.arange(n)
    off_mask = (sub[None, :] < sub[:, None])[:, None, :, None]
    off = jnp.einsum('bhaik,bhacjk->bhaicj', q_rel, k_rel) * off_mask
    pos = jnp.arange(SUB_CHUNK)
    tri = pos[:, None] >= pos[None, :]
    decay = jnp.exp(jnp.minimum(bs[:, :, :, :, None] - bs[:, :, :, None, :], 0.0))
    diag = jnp.einsum('bhaik,bhajk,bhaijk->bhaij', qs, ks, decay) * tri
    scores = off + jnp.einsum('bhaij,ac->bhaicj', diag, jnp.eye(n, dtype=diag.dtype))
    o = o + jnp.einsum('bhts,bhsv->bhtv', scores.reshape(bn, h, c, c), v)
    b_last = b[:, :, -1]
    S_new = jnp.exp(b_last)[..., None] * S + jnp.einsum('bhsk,bhsv->bhkv', k * jnp.exp(jnp.minimum(b_last[:, :, None] - b, 0.0)), v)
    return S_new, o


def hgrn2(q, k, v, logf, S0):
    bn, t = q.shape[:2]
    nc = -(-t // CHUNK)
    pad = nc * CHUNK - t

    def prep(a):
        a = jnp.pad(a.astype(jnp.float32), ((0, 0), (0, pad), (0, 0), (0, 0)))
        return a.reshape(bn, nc, CHUNK, N_HEADS, HEAD_DIM).transpose(1, 0, 3, 2, 4)

    S, o = lax.scan(hgrn2_chunk, S0.astype(jnp.float32), (prep(q), prep(k), prep(v), prep(logf)))
    o = o.transpose(1, 0, 3, 2, 4).reshape(bn, nc * CHUNK, N_HEADS, HEAD_DIM)[:, :t]
    return o, S


def attn_mixer(h, w_in, q_w, k_w, past_k, past_v):
    bn, t = h.shape[:2]
    qa, ka, va, g = jnp.split(h @ w_in, N_PROJ, axis=-1)
    q = rms_norm(qa.reshape(bn, t, N_HEADS, HEAD_DIM), q_w)
    k = rms_norm(ka.reshape(bn, t, N_HEADS, HEAD_DIM), k_w)
    v = va.reshape(bn, t, N_HEADS, HEAD_DIM)
    if past_k is None:
        kk, vv, off = k, v, 0
    else:
        kk = jnp.concatenate([past_k.astype(k.dtype), k], axis=1)
        vv = jnp.concatenate([past_v.astype(v.dtype), v], axis=1)
        off = past_k.shape[1]
    o = stick_breaking(q, kk, vv, off).reshape(bn, t, D_MODEL)
    return o * jax.nn.silu(g), k, v


def hgrn_mixer(h, w_in, lb, out_w, S0):
    bn, t = h.shape[:2]
    qa, fa, ia, g = jnp.split(h @ w_in, N_PROJ, axis=-1)
    f32 = fa.astype(jnp.float32)
    logf = jnp.logaddexp(jnp.log(jnp.maximum(lb, LB_FLOOR)), jnp.log1p(-lb) + jax.nn.log_sigmoid(f32))
    logf = jnp.minimum(logf, 0.0)
    kk = (1.0 - lb) * jax.nn.sigmoid(-f32)
    heads = lambda a: a.reshape(bn, t, N_HEADS, HEAD_DIM)
    o, S = hgrn2(heads(jax.nn.silu(qa)), heads(kk), heads(ia), heads(logf), S0)
    o = rms_norm(o, out_w).reshape(bn, t, D_MODEL).astype(h.dtype)
    return o * jax.nn.silu(g), S


def setup_inputs(seed: int = 0) -> dict:
    key = jax.random.key(seed)
    ks = jax.random.split(key, 13)
    nrm = jax.random.normal
    scale = D_MODEL ** -0.5
    return {
        'x_prompt': nrm(ks[0], (BATCH, SEQ, D_MODEL), jnp.float32),
        'x_sample': nrm(ks[1], (DEC_BATCH, DEC_SEQ, D_MODEL), jnp.float32),
        'cache_k': nrm(ks[2], (N_ATTN, DEC_BATCH, PAST_LEN, N_HEADS, HEAD_DIM), jnp.float32),
        'cache_v': nrm(ks[3], (N_ATTN, DEC_BATCH, PAST_LEN, N_HEADS, HEAD_DIM), jnp.float32),
        'state_hgrn': 0.5 * nrm(ks[4], (N_HGRN, DEC_BATCH, N_HEADS, HEAD_DIM, HEAD_DIM), jnp.float32),
        'norm_w': 1.0 + 0.02 * nrm(ks[5], (DEPTH, D_MODEL), jnp.float32),
        'w_in': scale * nrm(ks[6], (DEPTH, D_MODEL, N_PROJ * D_MODEL), jnp.float32),
        'w_out': scale * nrm(ks[7], (DEPTH, D_MODEL, D_MODEL), jnp.float32),
        'q_norm_w': 1.0 + 0.02 * nrm(ks[8], (N_ATTN, HEAD_DIM), jnp.float32),
        'k_norm_w': 1.0 + 0.02 * nrm(ks[9], (N_ATTN, HEAD_DIM), jnp.float32),
        'hgrn_norm_w': 1.0 + 0.02 * nrm(ks[10], (N_HGRN, HEAD_DIM), jnp.float32),
        'hgrn_lb': 0.5 * nrm(ks[11], (N_HGRN, D_MODEL), jnp.float32),
    }


def reference(x_prompt, x_sample, cache_k, cache_v, state_hgrn, norm_w, w_in, w_out,
              q_norm_w, k_norm_w, hgrn_norm_w, hgrn_lb):
    lb_sm = jax.nn.softmax(hgrn_lb.astype(jnp.float32), axis=0)
    lbs = jnp.clip(jnp.cumsum(lb_sm, axis=0) - lb_sm[0], 0.0, 1.0 - 1e-6)
    xp, xs = x_prompt, x_sample
    kp, vp, sp, ksm, vsm, ssm = [], [], [], [], [], []
    for layer in range(DEPTH):
        j = layer // N_MIXERS
        hp = rms_norm(xp, norm_w[layer])
        hs = rms_norm(xs, norm_w[layer])
        if layer % N_MIXERS == 0:
            op, k1, v1 = attn_mixer(hp, w_in[layer], q_norm_w[j], k_norm_w[j], None, None)
            osm, k2, v2 = attn_mixer(hs, w_in[layer], q_norm_w[j], k_norm_w[j], cache_k[j], cache_v[j])
            kp.append(k1); vp.append(v1); ksm.append(k2); vsm.append(v2)
        else:
            s0 = jnp.zeros((xp.shape[0], N_HEADS, HEAD_DIM, HEAD_DIM), jnp.float32)
            op, s1 = hgrn_mixer(hp, w_in[layer], lbs[j], hgrn_norm_w[j], s0)
            osm, s2 = hgrn_mixer(hs, w_in[layer], lbs[j], hgrn_norm_w[j], state_hgrn[j])
            sp.append(s1); ssm.append(s2)
        xp = xp + op @ w_out[layer]
        xs = xs + osm @ w_out[layer]
    return (xp, xs, jnp.stack(kp), jnp.stack(vp), jnp.stack(sp), jnp.stack(ksm), jnp.stack(vsm), jnp.stack(ssm))
```

```cpp
#include <hip/hip_runtime.h>
#include <cstdio>
#include <cstdint>
#include <cstring>
namespace pg8 {
#define PG8_LAS __attribute__((address_space(3)))
typedef unsigned short bf16_t;
typedef short bf16x8 __attribute__((ext_vector_type(8)));
typedef float f32x4 __attribute__((ext_vector_type(4)));
typedef unsigned u32x4 __attribute__((ext_vector_type(4)));
constexpr int BM = 256, BK = 64, HALF = 128, HTB = HALF * BK * 2  , STAGE_BYTES = 8 * HTB, NXCD = 8, WGM = 8;

__host__ __device__ __forceinline__ int lds_byte(int r, int c) { const int st = (r >> 4) * 2 + (c >> 5), rr = r & 15, cc = c & 31, ob = rr * 64 + cc * 2; return st * 1024 + (ob ^ (((ob >> 9) & 1) << 5)); }
__host__ __device__ __forceinline__ void stage_rc(int b, int& R, int& C) { const int st = b / 1024, sb = b % 1024, swz = sb ^ (((sb >> 9) & 1) << 5); R = (st >> 1) * 16 + swz / 64; C = (st & 1) * 32 + (swz % 64) / 2; }
__host__ __device__ __forceinline__ int perm32(int rho) { const int n = rho >> 4, i = rho & 15; return 8 * (i >> 2) + 4 * n + (i & 3); }

struct Unit { int pm, pn; };
struct Gemm { const bf16_t* A; const bf16_t* Bt; int M, N, K; };

struct StaticOrder {
    int nM, nN, nwg, G, c;
    __host__ __device__ void init(int M, int N, int G_, int c_) { nM = M / BM; nN = N / BM; nwg = nM * nN; G = G_; c = c_; }
    __host__ __device__ bool next(int i, Unit& u) const {
        const long L = (long)i * G + c; if (L >= nwg) return false;
        int wgid = (int)L; { const int q = nwg / NXCD, r = nwg % NXCD, xcd = wgid % NXCD, off = wgid / NXCD; wgid = (xcd < r ? xcd * (q + 1) : r * (q + 1) + (xcd - r) * q) + off; }
        const int nig = WGM * nN, gid = wgid / nig, fm = gid * WGM, gsz = (nM - fm) < WGM ? (nM - fm) : WGM;
        u.pm = fm + ((wgid % nig) % gsz); u.pn = (wgid % nig) / gsz; return true;
    }
    __device__ __forceinline__ void a_ready(const Unit&) const {}
    __device__ __forceinline__ void done(const Unit&) const {}
};

__device__ __forceinline__ unsigned cvt_pk_bf16(float lo, float hi) { unsigned r; asm volatile("v_cvt_pk_bf16_f32 %0, %1, %2" : "=v"(r) : "v"(lo), "v"(hi)); return r; }
typedef float f32x2 __attribute__((ext_vector_type(2)));
template <class Epi, class Sched, bool ALIGN_EPI = false, bool SP2 = false>
__device__ __forceinline__ void gemm_phase(PG8_LAS unsigned char* lds, const Gemm g, const Sched& S, const Epi& E) {
    const int tid = threadIdx.x, wid = __builtin_amdgcn_readfirstlane(tid >> 6), lane = tid & 63, wr = wid >> 2, wc = wid & 3, fr = lane & 15, fq = lane >> 4;
    const int K = g.K, nt = K / BK;
    unsigned voffA[2], voffB[2];
#pragma unroll
    for (int i = 0; i < 2; ++i) { int R, C; stage_rc(tid * 16 + i * 8192, R, C); const int Rb = Epi::PERM ? ((R & ~31) + perm32(R & 31)) : R;
        voffA[i] = (unsigned)(R * K + C) * 2u; voffB[i] = (unsigned)(Rb * K + C) * 2u; }
    const size_t kstep = (size_t)(BK * 2);
    const size_t hstep = (size_t)HALF * K * 2;
    const size_t tstep = 2 * hstep;
    const unsigned ldsw = (unsigned)wid * 1024u;
    const int aoff = lds_byte(wr * 64 + fr, fq * 8), boff = lds_byte(wc * 32 + fr, fq * 8);
#define PG8_SA(b, h) (((b) * 2 + (h)) * HTB)
#define PG8_SB(b, h) ((4 + (b) * 2 + (h)) * HTB)
#define PG8_STAGE(bufoff, gbase, voff) do { _Pragma("unroll") for (int _i = 0; _i < 2; ++_i) \
        __builtin_amdgcn_global_load_lds((const unsigned*)((const char*)(gbase) + (voff)[_i]), (PG8_LAS unsigned*)(lds + (bufoff) + ldsw + _i * 8192), 16, 0, 0); } while (0)
#define PG8_LDA(dst, b, h) do { _Pragma("unroll") for (int m = 0; m < 4; ++m) _Pragma("unroll") for (int k = 0; k < 2; ++k) dst[m][k] = *(const PG8_LAS bf16x8*)(lds + PG8_SA(b, h) + aoff + m * 2048 + k * 1024); } while (0)
#define PG8_LDB(dst, b, h) do { _Pragma("unroll") for (int n = 0; n < 2; ++n) _Pragma("unroll") for (int k = 0; k < 2; ++k) dst[n][k] = *(const PG8_LAS bf16x8*)(lds + PG8_SB(b, h) + boff + n * 2048 + k * 1024); } while (0)
#define PG8_MMA(ai, bj, At, Bt) do { __builtin_amdgcn_s_setprio(1); _Pragma("unroll") for (int m = 0; m < 4; ++m) _Pragma("unroll") for (int n = 0; n < 2; ++n) _Pragma("unroll") for (int k = 0; k < 2; ++k) \
        acc[ai][bj][m][n] = __builtin_amdgcn_mfma_f32_16x16x32_bf16(Bt[n][k], At[m][k], acc[ai][bj][m][n], 0, 0, 0); __builtin_amdgcn_s_setprio(0); } while (0)
#define PG8_WAIT_V(n) asm volatile("s_waitcnt vmcnt(" #n ")" ::: "memory")
#define PG8_WAIT_L(n) asm volatile("s_waitcnt lgkmcnt(" #n ")" ::: "memory")
#define PG8_BAR __builtin_amdgcn_s_barrier()
#define PG8_SCHED __builtin_amdgcn_sched_barrier(0)
    Unit cur, nxt; int ui = 0;
    if (!S.next(0, cur)) return;
    f32x4 acc[2][2][4][2];
#pragma unroll
    for (int a = 0; a < 2; ++a)
#pragma unroll
        for (int b = 0; b < 2; ++b)
#pragma unroll
            for (int m = 0; m < 4; ++m)
#pragma unroll
                for (int n = 0; n < 2; ++n) acc[a][b][m][n] = (f32x4){0.f, 0.f, 0.f, 0.f};
    bf16x8 At[4][2], B0[2][2], B1[2][2];
    const char* cA = (const char*)g.A + (size_t)cur.pm * tstep; const char* cB = (const char*)g.Bt + (size_t)cur.pn * tstep;
    S.a_ready(cur);
    if constexpr (SP2) {
        PG8_STAGE(PG8_SB(0, 0), cB, voffB); PG8_STAGE(PG8_SB(0, 1), cB + hstep, voffB); PG8_STAGE(PG8_SA(0, 0), cA, voffA); PG8_STAGE(PG8_SA(0, 1), cA + hstep, voffA);
        if (wr == 1) PG8_BAR;
        PG8_WAIT_V(2); PG8_BAR;
        PG8_STAGE(PG8_SB(1, 0), cB + kstep, voffB); PG8_STAGE(PG8_SA(1, 0), cA + kstep, voffA); PG8_STAGE(PG8_SB(1, 1), cB + hstep + kstep, voffB);
        PG8_WAIT_V(6); PG8_BAR;
    } else {
        PG8_STAGE(PG8_SB(0, 0), cB, voffB); PG8_STAGE(PG8_SA(0, 0), cA, voffA); PG8_STAGE(PG8_SB(0, 1), cB + hstep, voffB); PG8_STAGE(PG8_SA(0, 1), cA + hstep, voffA);
        if (wr == 1) PG8_BAR;
        PG8_WAIT_V(4); PG8_BAR;
        PG8_STAGE(PG8_SB(1, 0), cB + kstep, voffB); PG8_STAGE(PG8_SA(1, 0), cA + kstep, voffA); PG8_STAGE(PG8_SB(1, 1), cB + hstep + kstep, voffB);
        PG8_WAIT_V(6); PG8_BAR;
    }
    for (;;) {
        const bool has_next = S.next(ui + 1, nxt);
        const char* nA = has_next ? (const char*)g.A + (size_t)nxt.pm * tstep : cA; const char* nB = has_next ? (const char*)g.Bt + (size_t)nxt.pn * tstep : cB;
        for (int t = 0; t < nt; t += 2) {
            const bool last = (t == nt - 2);
            const char* a1 = cA + (size_t)(t + 1) * kstep;
            const char* a2 = last ? nA : cA + (size_t)(t + 2) * kstep; const char* b2 = last ? nB : cB + (size_t)(t + 2) * kstep;
            const char* a3 = a2 + kstep; const char* b3 = b2 + kstep;
            if (last && has_next) S.a_ready(nxt);
            if constexpr (SP2) {
            PG8_LDB(B0, 0, 0); PG8_LDB(B1, 0, 1); PG8_SCHED; PG8_LDA(At, 0, 0); PG8_STAGE(PG8_SA(1, 1), a1 + hstep, voffA);
            PG8_WAIT_V(8); PG8_WAIT_L(0); PG8_BAR; PG8_MMA(0, 0, At, B0); PG8_MMA(0, 1, At, B1); PG8_BAR; PG8_SCHED;
            PG8_LDA(At, 0, 1); PG8_STAGE(PG8_SB(0, 0), b2, voffB); PG8_STAGE(PG8_SB(0, 1), b2 + hstep, voffB); PG8_STAGE(PG8_SA(0, 0), a2, voffA);
            PG8_WAIT_V(8); PG8_WAIT_L(0); PG8_BAR; PG8_MMA(1, 0, At, B0); PG8_MMA(1, 1, At, B1); PG8_BAR; PG8_SCHED;
            PG8_LDB(B0, 1, 0); PG8_LDB(B1, 1, 1); PG8_SCHED; PG8_LDA(At, 1, 0); PG8_STAGE(PG8_SA(0, 1), a2 + hstep, voffA);
            PG8_WAIT_V(8); PG8_WAIT_L(0); PG8_BAR; PG8_MMA(0, 0, At, B0); PG8_MMA(0, 1, At, B1); PG8_BAR; PG8_SCHED;
            PG8_LDA(At, 1, 1); PG8_STAGE(PG8_SB(1, 0), b3, voffB); PG8_STAGE(PG8_SB(1, 1), b3 + hstep, voffB); PG8_STAGE(PG8_SA(1, 0), a3, voffA);
            PG8_WAIT_V(8); PG8_WAIT_L(0); PG8_BAR; PG8_MMA(1, 0, At, B0); PG8_MMA(1, 1, At, B1); PG8_BAR; PG8_SCHED;
            } else {
            PG8_LDB(B0, 0, 0); PG8_SCHED; PG8_LDA(At, 0, 0); PG8_STAGE(PG8_SA(1, 1), a1 + hstep, voffA);
            PG8_WAIT_L(8); PG8_BAR; PG8_WAIT_L(0); PG8_MMA(0, 0, At, B0); PG8_BAR; PG8_SCHED;
            PG8_LDB(B1, 0, 1); PG8_STAGE(PG8_SB(0, 0), b2, voffB);
            PG8_BAR; PG8_WAIT_L(0); PG8_MMA(0, 1, At, B1); PG8_BAR;
            PG8_LDA(At, 0, 1); PG8_STAGE(PG8_SA(0, 0), a2, voffA);
            PG8_BAR; PG8_WAIT_L(0); PG8_MMA(1, 0, At, B0); PG8_BAR; PG8_SCHED;
            PG8_STAGE(PG8_SB(0, 1), b2 + hstep, voffB);
            PG8_WAIT_V(6); PG8_BAR; PG8_MMA(1, 1, At, B1); PG8_BAR;
            PG8_LDB(B0, 1, 0); PG8_SCHED; PG8_LDA(At, 1, 0); PG8_STAGE(PG8_SA(0, 1), a2 + hstep, voffA);
            PG8_WAIT_L(8); PG8_BAR; PG8_WAIT_L(0); PG8_MMA(0, 0, At, B0); PG8_BAR; PG8_SCHED;
            PG8_LDB(B1, 1, 1); PG8_STAGE(PG8_SB(1, 0), b3, voffB);
            PG8_BAR; PG8_WAIT_L(0); PG8_MMA(0, 1, At, B1); PG8_BAR;
            PG8_LDA(At, 1, 1); PG8_STAGE(PG8_SA(1, 0), a3, voffA);
            PG8_BAR; PG8_WAIT_L(0); PG8_MMA(1, 0, At, B0); PG8_BAR; PG8_SCHED;
            PG8_STAGE(PG8_SB(1, 1), b3 + hstep, voffB);
            PG8_WAIT_V(6); PG8_BAR; PG8_MMA(1, 1, At, B1); PG8_BAR;
            }
        }
        if constexpr (ALIGN_EPI) { if (wr == 0) PG8_BAR; }
        if constexpr (!Epi::AFTER_DRAIN) { E(acc, cur, wr, wc, fr, fq); S.done(cur); }
        if (!has_next) break;
#pragma unroll
        for (int a = 0; a < 2; ++a)
#pragma unroll
            for (int b = 0; b < 2; ++b)
#pragma unroll
                for (int m = 0; m < 4; ++m)
#pragma unroll
                    for (int n = 0; n < 2; ++n) acc[a][b][m][n] = (f32x4){0.f, 0.f, 0.f, 0.f};
        cur = nxt; cA = nA; cB = nB; ++ui;
        if constexpr (ALIGN_EPI) { if (wr == 1) PG8_BAR; }
    }
    PG8_WAIT_V(0);
    if constexpr (!ALIGN_EPI) { if (wr == 0) PG8_BAR; }
    PG8_BAR;
    if constexpr (Epi::AFTER_DRAIN) { E.fused(acc, cur, wr, wc, fr, fq, lds, wid, lane); S.done(cur); }
#undef PG8_SA
#undef PG8_SB
#undef PG8_STAGE
#undef PG8_LDA
#undef PG8_LDB
#undef PG8_MMA
#undef PG8_WAIT_V
#undef PG8_WAIT_L
#undef PG8_BAR
#undef PG8_SCHED
}
}

constexpr int D = 2048, NH = 16, HD = 128, NP = 8192, DEPTH = 4;
constexpr int BP = 4, TP = 4096, MP = BP * TP;
constexpr int BS = 16, TS = 32, MS = BS * TS, PAST = 2048;
constexpr int M = MP + MS;
constexpr float EPS = 1e-6f;
constexpr float LOG2E = 1.4426950408889634f;
constexpr float QSCALE = 0.08838834764831845f * LOG2E;
constexpr float SB_EXIT = -150.0f;
constexpr size_t O_YP = 0, O_YS = O_YP + (size_t)MP * D, O_KP = O_YS + (size_t)MS * D, O_VP = O_KP + 2 * (size_t)MP * D, O_SP = O_VP + 2 * (size_t)MP * D,
                 O_KS = O_SP + 2 * (size_t)BP * NH * HD * HD, O_VS = O_KS + 2 * (size_t)MS * D, O_SS = O_VS + 2 * (size_t)MS * D, O_END = O_SS + 2 * (size_t)BS * NH * HD * HD;
static_assert(O_END == 183500800ull, "output size");
constexpr size_t MiB = 1u << 20;
constexpr size_t WS_CTL = 0, CTL_BYTES = 1 * MiB;
constexpr size_t WS_WIN = 1 * MiB;
constexpr size_t WS_WOUT = 129 * MiB;
constexpr size_t WS_XB = 161 * MiB;
constexpr size_t WS_SSQ = 227 * MiB;
constexpr size_t WS_QB = 228 * MiB, WS_KB = 294 * MiB, WS_VB = 360 * MiB, WS_GB = 426 * MiB;
constexpr size_t WS_LF = 492 * MiB;
constexpr size_t WS_OG = 624 * MiB;
constexpr size_t WS_HL = 690 * MiB;
constexpr size_t WS_PROJ = 706 * MiB;
constexpr size_t WS_TMP = 1234 * MiB;
constexpr size_t WS_END = 1366 * MiB;

#define LAS __attribute__((address_space(3)))
typedef unsigned short bf16;
typedef float f32x4 __attribute__((ext_vector_type(4)));
typedef float f32x2 __attribute__((ext_vector_type(2)));
typedef unsigned u32x4 __attribute__((ext_vector_type(4)));
typedef unsigned u32x2 __attribute__((ext_vector_type(2)));
__device__ __forceinline__ float bf2f(unsigned short b) { return __uint_as_float(((unsigned)b) << 16); }
__device__ __forceinline__ float bflo(unsigned w) { return __uint_as_float(w << 16); }
__device__ __forceinline__ float bfhi(unsigned w) { return __uint_as_float(w & 0xffff0000u); }
__device__ __forceinline__ unsigned f2bf(float f) { unsigned u = __float_as_uint(f); return (u + 0x7fffu + ((u >> 16) & 1u)) >> 16; }
__device__ __forceinline__ unsigned pk2(float lo, float hi) { return f2bf(lo) | (f2bf(hi) << 16); }
__device__ __forceinline__ float wave_sum(float v) {
#pragma unroll
    for (int o = 1; o < 64; o <<= 1) v += __shfl_xor(v, o);
    return v;
}
__device__ __forceinline__ float silu_f(float x) { return x / (1.0f + __expf(-x)); }

struct Args { const float* in[12]; float* out; unsigned char* ws; int layer; int pad; };

__device__ __forceinline__ float row_rstd(const float* ssq, int row) {
    const f32x4 a = *(const f32x4*)(ssq + (size_t)row * 8), b = *(const f32x4*)(ssq + (size_t)row * 8 + 4);
    const float s = ((a.x + a.y) + (a.z + a.w)) + ((b.x + b.y) + (b.z + b.w));
    return rsqrtf(s * (1.0f / D) + EPS);
}
__device__ __forceinline__ float hgrn_lower_bound(const float* hgrn_lb, int j, int c) {
    if (j == 0) return 0.0f;
    const float l0 = hgrn_lb[c], l1 = hgrn_lb[D + c], mx = fmaxf(l0, l1), e0 = __expf(l0 - mx), e1 = __expf(l1 - mx);
    return fminf(fmaxf(e1 / (e0 + e1), 0.0f), 1.0f - 1e-6f);
}

__device__ __forceinline__ void transpose_item(const float* W, const float* kscale, int K, int N, bf16* WT, float* scr, int item, int lane) {
    const int nblk = N / 32, kb = item / nblk, nb = item % nblk, k0 = 64 * kb, n0 = 32 * nb;
#pragma unroll 8
    for (int i = 0; i < 32; ++i) { const int kk = 2 * i + (lane >> 5); const float sc = kscale ? kscale[k0 + kk] : 1.0f;
        scr[kk * 33 + (lane & 31)] = W[(size_t)(k0 + kk) * N + n0 + (lane & 31)] * sc; }
    __builtin_amdgcn_s_waitcnt(0); asm volatile("" ::: "memory");
    const int c = lane & 7;
#pragma unroll
    for (int j = 0; j < 4; ++j) { const int n = (lane >> 3) + 8 * j; const float* s = scr + (8 * c) * 33 + n;
        u32x4 o; o.x = pk2(s[0 * 33], s[1 * 33]); o.y = pk2(s[2 * 33], s[3 * 33]); o.z = pk2(s[4 * 33], s[5 * 33]); o.w = pk2(s[6 * 33], s[7 * 33]);
        *(u32x4*)(WT + (size_t)(n0 + n) * K + k0 + 8 * c) = o; }
    __builtin_amdgcn_s_waitcnt(0); asm volatile("" ::: "memory");
}
__device__ __forceinline__ void prologue_phase(const Args& a, unsigned char* shm, int bid, int nblk) {
    const int tid = threadIdx.x, lane = tid & 63, wave = tid >> 6;
    float* scr = (float*)shm + wave * (64 * 33);
    const int gw = bid * 8 + wave, NGW = nblk * 8;
    const float* norm_w = a.in[5]; const float* w_in = a.in[6]; const float* w_out = a.in[7];
    bf16* WinT = (bf16*)(a.ws + WS_WIN); bf16* WoutT = (bf16*)(a.ws + WS_WOUT);
    constexpr int I_IN = (D / 64) * (NP / 32), I_OUT = (D / 64) * (D / 32);
    for (int it = gw; it < DEPTH * (I_IN + I_OUT); it += NGW) {
        const int l = it / (I_IN + I_OUT), r = it % (I_IN + I_OUT);
        if (r < I_IN) transpose_item(w_in + (size_t)l * D * NP, norm_w + l * D, D, NP, WinT + (size_t)l * NP * D, scr, r, lane);
        else transpose_item(w_out + (size_t)l * D * D, nullptr, D, D, WoutT + (size_t)l * D * D, scr, r - I_IN, lane);
    }
    bf16* XB = (bf16*)(a.ws + WS_XB); float* ssq = (float*)(a.ws + WS_SSQ);
    for (int row = gw; row < M; row += NGW) {
        const float* src = row < MP ? a.in[0] + (size_t)row * D : a.in[1] + (size_t)(row - MP) * D;
        float s = 0.f;
#pragma unroll
        for (int j = 0; j < 8; ++j) { const f32x4 v = *(const f32x4*)(src + 4 * (lane + 64 * j)); s += (v.x * v.x + v.y * v.y) + (v.z * v.z + v.w * v.w);
            u32x2 o; o.x = pk2(v.x, v.y); o.y = pk2(v.z, v.w); *(u32x2*)(XB + (size_t)row * D + 4 * (lane + 64 * j)) = o; }
        s = wave_sum(s);
        if (lane < 8) ssq[(size_t)row * 8 + lane] = lane == 0 ? s : 0.f;
    }
}
__global__ __launch_bounds__(512) void k_prep(Args a) {
    extern __shared__ __attribute__((aligned(16))) unsigned char shm[];
    prologue_phase(a, shm, blockIdx.x, gridDim.x);
}

struct EpiF32 {
    static constexpr bool PERM = false, AFTER_DRAIN = false;
    float* C; int ldc;
    __device__ __forceinline__ void operator()(const pg8::f32x4 (&acc)[2][2][4][2], const pg8::Unit& u, int wr, int wc, int fr, int fq) const {
        const int row0 = u.pm * 256 + wr * 64 + fr, col0 = u.pn * 256 + wc * 32 + 4 * fq;
#pragma unroll
        for (int ai = 0; ai < 2; ++ai)
#pragma unroll
            for (int m = 0; m < 4; ++m) { float* rowp = C + (size_t)(row0 + ai * 128 + m * 16) * ldc + col0;
#pragma unroll
                for (int bj = 0; bj < 2; ++bj)
#pragma unroll
                    for (int n = 0; n < 2; ++n) *(pg8::f32x4*)(rowp + bj * 128 + n * 16) = acc[ai][bj][m][n]; }
    }
};
__global__ __launch_bounds__(512, 2) void k_gemm1_base(Args a) {
    extern __shared__ __attribute__((aligned(16))) unsigned char shm[];
    pg8::Gemm g{(const bf16*)(a.ws + WS_XB), (const bf16*)(a.ws + WS_WIN) + (size_t)a.layer * NP * D, M, NP, D};
    pg8::StaticOrder S; S.init(M, NP, (int)gridDim.x, (int)blockIdx.x);
    EpiF32 E{(float*)(a.ws + WS_PROJ), NP};
    pg8::gemm_phase<EpiF32, pg8::StaticOrder, true, true>((LAS unsigned char*)shm, g, S, E);
}
__global__ __launch_bounds__(512, 2) void k_gemm2_base(Args a) {
    extern __shared__ __attribute__((aligned(16))) unsigned char shm[];
    pg8::Gemm g{(const bf16*)(a.ws + WS_OG), (const bf16*)(a.ws + WS_WOUT) + (size_t)a.layer * D * D, M, D, D};
    pg8::StaticOrder S; S.init(M, D, (int)gridDim.x, (int)blockIdx.x);
    EpiF32 E{(float*)(a.ws + WS_TMP), D};
    pg8::gemm_phase<EpiF32, pg8::StaticOrder, true, true>((LAS unsigned char*)shm, g, S, E);
}

__global__ __launch_bounds__(512) void k_post_attn(Args a) {
    const int tid = threadIdx.x, lane = tid & 63, wave = tid >> 6, gw = blockIdx.x * 8 + wave, NGW = gridDim.x * 8, j = a.layer >> 1;
    const float* PROJ = (const float*)(a.ws + WS_PROJ); const float* ssq = (const float*)(a.ws + WS_SSQ);
    bf16* QB = (bf16*)(a.ws + WS_QB); bf16* KB = (bf16*)(a.ws + WS_KB); bf16* VB = (bf16*)(a.ws + WS_VB); bf16* GB = (bf16*)(a.ws + WS_GB);
    const float* qw = a.in[8] + j * HD; const float* kw = a.in[9] + j * HD;
    for (int task = gw; task < M * NH; task += NGW) {
        const int row = task / NH, h = task % NH; const float rs = row_rstd(ssq, row);
        const float* p = PROJ + (size_t)row * NP + h * HD + 2 * lane;
        f32x2 qa = *(const f32x2*)p * rs, ka = *(const f32x2*)(p + D) * rs, va = *(const f32x2*)(p + 2 * D) * rs, ga = *(const f32x2*)(p + 3 * D) * rs;
        const float rq = rsqrtf(wave_sum(qa.x * qa.x + qa.y * qa.y) * (1.0f / HD) + EPS), rk = rsqrtf(wave_sum(ka.x * ka.x + ka.y * ka.y) * (1.0f / HD) + EPS);
        const f32x2 qwv = *(const f32x2*)(qw + 2 * lane), kwv = *(const f32x2*)(kw + 2 * lane);
        const f32x2 q = qa * rq * qwv * QSCALE, k = ka * rk * kwv;
        const size_t o = (size_t)row * D + h * HD + 2 * lane;
        *(unsigned*)(QB + o) = pk2(q.x, q.y); *(unsigned*)(KB + o) = pk2(k.x, k.y); *(unsigned*)(VB + o) = pk2(va.x, va.y); *(unsigned*)(GB + o) = pk2(silu_f(ga.x), silu_f(ga.y));
        float* ko = row < MP ? a.out + O_KP + (size_t)j * MP * D + o : a.out + O_KS + (size_t)j * MS * D + (o - (size_t)MP * D);
        float* vo = row < MP ? a.out + O_VP + (size_t)j * MP * D + o : a.out + O_VS + (size_t)j * MS * D + (o - (size_t)MP * D);
        *(f32x2*)ko = k; *(f32x2*)vo = va;
    }
}
__global__ __launch_bounds__(512) void k_post_hgrn(Args a) {
    const int j = a.layer >> 1;
    const float* PROJ = (const float*)(a.ws + WS_PROJ); const float* ssq = (const float*)(a.ws + WS_SSQ);
    bf16* QB = (bf16*)(a.ws + WS_QB); bf16* VB = (bf16*)(a.ws + WS_VB); bf16* GB = (bf16*)(a.ws + WS_GB); float* LF = (float*)(a.ws + WS_LF);
    for (size_t i = (size_t)blockIdx.x * 512 + threadIdx.x; i < (size_t)M * (D / 2); i += (size_t)gridDim.x * 512) {
        const int row = (int)(i / (D / 2)), c = (int)(i % (D / 2)) * 2; const float rs = row_rstd(ssq, row);
        const float* p = PROJ + (size_t)row * NP + c;
        const f32x2 qa = *(const f32x2*)p * rs, fa = *(const f32x2*)(p + D) * rs, ia = *(const f32x2*)(p + 2 * D) * rs, ga = *(const f32x2*)(p + 3 * D) * rs;
        const float lb0 = hgrn_lower_bound(a.in[11], j, c), lb1 = hgrn_lower_bound(a.in[11], j, c + 1);
        const float k0 = (1.0f - lb0) / (1.0f + __expf(fa.x)), k1 = (1.0f - lb1) / (1.0f + __expf(fa.y));
        f32x2 lf; lf.x = __logf(fmaxf(1.0f - k0, 1e-30f)); lf.y = __logf(fmaxf(1.0f - k1, 1e-30f));
        const size_t o = (size_t)row * D + c;
        *(unsigned*)(QB + o) = pk2(silu_f(qa.x), silu_f(qa.y)); *(unsigned*)(VB + o) = pk2(ia.x, ia.y); *(unsigned*)(GB + o) = pk2(silu_f(ga.x), silu_f(ga.y));
        *(f32x2*)(LF + o) = lf;
    }
}

__global__ __launch_bounds__(512) void k_attn_naive(Args a) {
    const int tid = threadIdx.x, lane = tid & 63, wave = tid >> 6, gw = blockIdx.x * 8 + wave, NGW = gridDim.x * 8, j = a.layer >> 1;
    const bf16* QB = (const bf16*)(a.ws + WS_QB); const bf16* KB = (const bf16*)(a.ws + WS_KB); const bf16* VB = (const bf16*)(a.ws + WS_VB); const bf16* GB = (const bf16*)(a.ws + WS_GB);
    bf16* OG = (bf16*)(a.ws + WS_OG);
    for (int task = gw; task < M * NH; task += NGW) {
        const int row = task / NH, h = task % NH; const size_t o = (size_t)row * D + h * HD + 2 * lane;
        const unsigned qw = *(const unsigned*)(QB + o); const float q0 = bflo(qw), q1 = bfhi(qw);
        int nnew, newbase, ncache = 0; const float* ck = nullptr; const float* cv = nullptr;
        if (row < MP) { nnew = row % TP; newbase = row - nnew; }
        else { const int rs = row - MP, bs = rs / TS; nnew = rs % TS; newbase = row - nnew; ncache = PAST;
               ck = a.in[2] + ((size_t)(j * BS + bs) * PAST) * D + h * HD + 2 * lane; cv = a.in[3] + ((size_t)(j * BS + bs) * PAST) * D + h * HD + 2 * lane; }
        float o0 = 0.f, o1 = 0.f, C = 0.f; bool done = false;
        for (int s = nnew - 1; s >= 0 && !done; --s) {
            const size_t ko = (size_t)(newbase + s) * D + h * HD + 2 * lane;
            const unsigned kw = *(const unsigned*)(KB + ko), vw = *(const unsigned*)(VB + ko);
            const float z = wave_sum(q0 * bflo(kw) + q1 * bfhi(kw));
            const float L = -(fmaxf(z, 0.f) + __log2f(1.0f + exp2f(-fabsf(z))));
            const float w = exp2f(z + L + C); o0 += w * bflo(vw); o1 += w * bfhi(vw); C += L; done = C < SB_EXIT;
        }
        for (int s = ncache - 1; s >= 0 && !done; --s) {
            const f32x2 kf = *(const f32x2*)(ck + (size_t)s * D), vf = *(const f32x2*)(cv + (size_t)s * D);
            const float z = wave_sum(q0 * kf.x + q1 * kf.y);
            const float L = -(fmaxf(z, 0.f) + __log2f(1.0f + exp2f(-fabsf(z))));
            const float w = exp2f(z + L + C); o0 += w * vf.x; o1 += w * vf.y; C += L; done = C < SB_EXIT;
        }
        const unsigned gw2 = *(const unsigned*)(GB + o);
        *(unsigned*)(OG + o) = pk2(o0 * bflo(gw2), o1 * bfhi(gw2));
    }
}

__global__ __launch_bounds__(512) void k_hgrn_naive(Args a) {
    extern __shared__ __attribute__((aligned(16))) unsigned char shm[];
    float* sq = (float*)shm; float* sf = sq + 4096; float* sk = sf + 4096; float* sv = sk + 4096; float* red = sv + 4096;
    const int tid = threadIdx.x, j = a.layer >> 1, dv = tid & 127, kq = tid >> 7;
    const bf16* QB = (const bf16*)(a.ws + WS_QB); const bf16* VB = (const bf16*)(a.ws + WS_VB); const bf16* GB = (const bf16*)(a.ws + WS_GB); const float* LF = (const float*)(a.ws + WS_LF);
    bf16* OG = (bf16*)(a.ws + WS_OG); const float* hw = a.in[10] + j * HD;
    for (int unit = blockIdx.x; unit < (BP + BS) * NH; unit += gridDim.x) {
        const bool prompt = unit < BP * NH; const int u = prompt ? unit : unit - BP * NH, b = u / NH, h = u % NH, T = prompt ? TP : TS, row0 = prompt ? b * TP : MP + b * TS;
        float S[32];
        const float* s0 = a.in[4] + (((size_t)(j * BS + b) * NH + h) * HD + 32 * kq) * HD + dv;
#pragma unroll
        for (int i = 0; i < 32; ++i) S[i] = prompt ? 0.f : s0[(size_t)i * HD];
        for (int t0 = 0; t0 < T; t0 += 32) {
            __syncthreads();
            for (int e = tid; e < 4096; e += 512) { const size_t idx = (size_t)(row0 + t0 + (e >> 7)) * D + h * HD + (e & 127);
                const float f = __expf(LF[idx]); sq[e] = bf2f(QB[idx]); sf[e] = f; sk[e] = 1.0f - f; sv[e] = bf2f(VB[idx]); }
            __syncthreads();
            for (int tt = 0; tt < 32; ++tt) { const float v = sv[tt * 128 + dv]; float po = 0.f;
#pragma unroll
                for (int i = 0; i < 32; ++i) { const int k = tt * 128 + 32 * kq + i; S[i] = sf[k] * S[i] + sk[k] * v; po += sq[k] * S[i]; }
                red[(tt * 4 + kq) * 128 + dv] = po; }
            __syncthreads();
            { const int tt = tid >> 4, c0 = (tid & 15) * 8; float o[8]; float ss = 0.f;
#pragma unroll
              for (int e = 0; e < 8; ++e) { o[e] = (red[(tt * 4 + 0) * 128 + c0 + e] + red[(tt * 4 + 1) * 128 + c0 + e]) + (red[(tt * 4 + 2) * 128 + c0 + e] + red[(tt * 4 + 3) * 128 + c0 + e]); ss += o[e] * o[e]; }
              ss += __shfl_xor(ss, 1); ss += __shfl_xor(ss, 2); ss += __shfl_xor(ss, 4); ss += __shfl_xor(ss, 8);
              const float rn = rsqrtf(ss * (1.0f / HD) + EPS); const size_t idx = (size_t)(row0 + t0 + tt) * D + h * HD + c0;
              const u32x4 g = *(const u32x4*)(GB + idx); u32x4 w;
              w.x = pk2(o[0] * rn * hw[c0 + 0] * bflo(g.x), o[1] * rn * hw[c0 + 1] * bfhi(g.x)); w.y = pk2(o[2] * rn * hw[c0 + 2] * bflo(g.y), o[3] * rn * hw[c0 + 3] * bfhi(g.y));
              w.z = pk2(o[4] * rn * hw[c0 + 4] * bflo(g.z), o[5] * rn * hw[c0 + 5] * bfhi(g.z)); w.w = pk2(o[6] * rn * hw[c0 + 6] * bflo(g.w), o[7] * rn * hw[c0 + 7] * bfhi(g.w));
              *(u32x4*)(OG + idx) = w; }
        }
        float* so = (prompt ? a.out + O_SP + (((size_t)(j * BP + b) * NH + h) * HD + 32 * kq) * HD : a.out + O_SS + (((size_t)(j * BS + b) * NH + h) * HD + 32 * kq) * HD) + dv;
#pragma unroll
        for (int i = 0; i < 32; ++i) so[(size_t)i * HD] = S[i];
    }
}

__global__ __launch_bounds__(512) void k_residual(Args a) {
    const int tid = threadIdx.x, lane = tid & 63, wave = tid >> 6, gw = blockIdx.x * 8 + wave, NGW = gridDim.x * 8, l = a.layer;
    const float* TMP = (const float*)(a.ws + WS_TMP); bf16* XB = (bf16*)(a.ws + WS_XB); float* ssq = (float*)(a.ws + WS_SSQ);
    for (int row = gw; row < M; row += NGW) {
        float* dst = row < MP ? a.out + O_YP + (size_t)row * D : a.out + O_YS + (size_t)(row - MP) * D;
        const float* base = l == 0 ? (row < MP ? a.in[0] + (size_t)row * D : a.in[1] + (size_t)(row - MP) * D) : dst;
        float s = 0.f;
#pragma unroll
        for (int j = 0; j < 8; ++j) { const int c = 4 * (lane + 64 * j); const f32x4 v = *(const f32x4*)(base + c) + *(const f32x4*)(TMP + (size_t)row * D + c);
            *(f32x4*)(dst + c) = v; s += (v.x * v.x + v.y * v.y) + (v.z * v.z + v.w * v.w);
            u32x2 o; o.x = pk2(v.x, v.y); o.y = pk2(v.z, v.w); *(u32x2*)(XB + (size_t)row * D + c) = o; }
        s = wave_sum(s);
        if (lane < 8) ssq[(size_t)row * 8 + lane] = lane == 0 ? s : 0.f;
    }
}

#define HIPCHK(x) do { hipError_t e_ = (x); if (e_ != hipSuccess) { fprintf(stderr, "kernel_launch: %s failed: %s\n", #x, hipGetErrorName(e_)); return; } } while (0)
extern "C" void kernel_launch(void* const* d_in, const int* in_sizes, int n_in, void* d_out, int out_size, void* d_ws, size_t ws_size, hipStream_t stream) {
    static int ready = 0;
    if (ready == 0) {
        if (n_in != 12 || (size_t)out_size != O_END || ws_size < WS_END) { fprintf(stderr, "kernel_launch: unexpected shapes n_in %d out %d ws %zu\n", n_in, out_size, ws_size); ready = -1; return; }
        HIPCHK(hipFuncSetAttribute((const void*)k_prep, hipFuncAttributeMaxDynamicSharedMemorySize, 8 * 64 * 33 * 4));
        HIPCHK(hipFuncSetAttribute((const void*)k_gemm1_base, hipFuncAttributeMaxDynamicSharedMemorySize, pg8::STAGE_BYTES));
        HIPCHK(hipFuncSetAttribute((const void*)k_gemm2_base, hipFuncAttributeMaxDynamicSharedMemorySize, pg8::STAGE_BYTES));
        HIPCHK(hipFuncSetAttribute((const void*)k_hgrn_naive, hipFuncAttributeMaxDynamicSharedMemorySize, 8 * 4096 * 4));
        ready = 1;
    }
    if (ready < 0) return;
    Args a; memset(&a, 0, sizeof(a));
    for (int i = 0; i < 12; ++i) a.in[i] = (const float*)d_in[i];
    a.out = (float*)d_out; a.ws = (unsigned char*)d_ws;
    const int G = 256;
    hipLaunchKernelGGL(k_prep, dim3(G), dim3(512), 8 * 64 * 33 * 4, stream, a);
    for (int l = 0; l < DEPTH; ++l) {
        a.layer = l;
        hipLaunchKernelGGL(k_gemm1_base, dim3(G), dim3(512), pg8::STAGE_BYTES, stream, a);
        if ((l & 1) == 0) { hipLaunchKernelGGL(k_post_attn, dim3(1024), dim3(512), 0, stream, a); hipLaunchKernelGGL(k_attn_naive, dim3(2048), dim3(512), 0, stream, a); }
        else { hipLaunchKernelGGL(k_post_hgrn, dim3(1024), dim3(512), 0, stream, a); hipLaunchKernelGGL(k_hgrn_naive, dim3((BP + BS) * NH), dim3(512), 8 * 4096 * 4, stream, a); }
        hipLaunchKernelGGL(k_gemm2_base, dim3(G), dim3(512), pg8::STAGE_BYTES, stream, a);
        hipLaunchKernelGGL(k_residual, dim3(1024), dim3(512), 0, stream, a);
    }
}
```

```cpp
#include <hip/hip_runtime.h>
#include <cstdio>
#include <cstdint>
#include <cstring>
__device__ __forceinline__ int fresh_tid() { int t = threadIdx.x; asm volatile("" : "+v"(t)); return t; }
namespace pg8 {
#define PG8_LAS __attribute__((address_space(3)))
typedef unsigned short bf16_t;
typedef short bf16x8 __attribute__((ext_vector_type(8)));
typedef float f32x4 __attribute__((ext_vector_type(4)));
typedef unsigned u32x4 __attribute__((ext_vector_type(4)));
constexpr int BM = 256, BK = 64, HALF = 128, HTB = HALF * BK * 2  , STAGE_BYTES = 8 * HTB, NXCD = 8, WGM = 8;

__host__ __device__ __forceinline__ int lds_byte(int r, int c) { const int st = (r >> 4) * 2 + (c >> 5), rr = r & 15, cc = c & 31, ob = rr * 64 + cc * 2; return st * 1024 + (ob ^ (((ob >> 9) & 1) << 5)); }
__host__ __device__ __forceinline__ void stage_rc(int b, int& R, int& C) { const int st = b / 1024, sb = b % 1024, swz = sb ^ (((sb >> 9) & 1) << 5); R = (st >> 1) * 16 + swz / 64; C = (st & 1) * 32 + (swz % 64) / 2; }
__host__ __device__ __forceinline__ int perm32(int rho) { const int n = rho >> 4, i = rho & 15; return 8 * (i >> 2) + 4 * n + (i & 3); }

struct Unit { int pm, pn; };
struct Gemm { const bf16_t* A; const bf16_t* Bt; int M, N, K; };

struct StaticOrder {
    int nM, nN, nwg, G, c, wgm;
    __host__ __device__ void init(int M, int N, int G_, int c_, int wgm_ = WGM) { nM = M / BM; nN = N / BM; nwg = nM * nN; G = G_; c = c_; wgm = wgm_; }
    __host__ __device__ bool next(int i, Unit& u) const {
        const long L = (long)i * G + c; if (L >= nwg) return false;
        int wgid = (int)L; { const int q = nwg / NXCD, r = nwg % NXCD, xcd = wgid % NXCD, off = wgid / NXCD; wgid = (xcd < r ? xcd * (q + 1) : r * (q + 1) + (xcd - r) * q) + off; }
        const int nig = wgm * nN, gid = wgid / nig, fm = gid * wgm, gsz = (nM - fm) < wgm ? (nM - fm) : wgm;
        u.pm = fm + ((wgid % nig) % gsz); u.pn = (wgid % nig) / gsz; return true;
    }
    __device__ __forceinline__ void a_ready(const Unit&) const {}
    __device__ __forceinline__ void done(const Unit&) const {}
};

__device__ __forceinline__ unsigned cvt_pk_bf16(float lo, float hi) { unsigned r; asm volatile("v_cvt_pk_bf16_f32 %0, %1, %2" : "=v"(r) : "v"(lo), "v"(hi)); return r; }
typedef float f32x2 __attribute__((ext_vector_type(2)));
template <class Epi, class Sched, bool ALIGN_EPI = false, bool SP2 = false>
__device__ __forceinline__ void gemm_phase(PG8_LAS unsigned char* lds, const Gemm g, const Sched& S, const Epi& E) {
    const int tid = fresh_tid(), wid = __builtin_amdgcn_readfirstlane(tid >> 6), lane = tid & 63, wr = wid >> 2, wc = wid & 3, fr = lane & 15, fq = lane >> 4;
    const int K = g.K, nt = K / BK;
    unsigned voffA[2], voffB[2];
#pragma unroll
    for (int i = 0; i < 2; ++i) { int R, C; stage_rc(tid * 16 + i * 8192, R, C); const int Rb = Epi::PERM ? ((R & ~31) + perm32(R & 31)) : R;
        voffA[i] = (unsigned)(R * K + C) * 2u; voffB[i] = (unsigned)(Rb * K + C) * 2u; }
    const size_t kstep = (size_t)(BK * 2);
    const size_t hstep = (size_t)HALF * K * 2;
    const size_t tstep = 2 * hstep;
    const unsigned ldsw = (unsigned)wid * 1024u;
    const int aoff = lds_byte(wr * 64 + fr, fq * 8), boff = lds_byte(wc * 32 + fr, fq * 8);
#define PG8_SA(b, h) (((b) * 2 + (h)) * HTB)
#define PG8_SB(b, h) ((4 + (b) * 2 + (h)) * HTB)
#define PG8_STAGE(bufoff, gbase, voff) do { _Pragma("unroll") for (int _i = 0; _i < 2; ++_i) \
        __builtin_amdgcn_global_load_lds((const unsigned*)((const char*)(gbase) + (voff)[_i]), (PG8_LAS unsigned*)(lds + (bufoff) + ldsw + _i * 8192), 16, 0, 0); } while (0)
#define PG8_LDA(dst, b, h) do { _Pragma("unroll") for (int m = 0; m < 4; ++m) _Pragma("unroll") for (int k = 0; k < 2; ++k) dst[m][k] = *(const PG8_LAS bf16x8*)(lds + PG8_SA(b, h) + aoff + m * 2048 + k * 1024); } while (0)
#define PG8_LDB(dst, b, h) do { _Pragma("unroll") for (int n = 0; n < 2; ++n) _Pragma("unroll") for (int k = 0; k < 2; ++k) dst[n][k] = *(const PG8_LAS bf16x8*)(lds + PG8_SB(b, h) + boff + n * 2048 + k * 1024); } while (0)
#define PG8_MMA(ai, bj, At, Bt) do { __builtin_amdgcn_s_setprio(1); _Pragma("unroll") for (int m = 0; m < 4; ++m) _Pragma("unroll") for (int n = 0; n < 2; ++n) _Pragma("unroll") for (int k = 0; k < 2; ++k) \
        acc[ai][bj][m][n] = __builtin_amdgcn_mfma_f32_16x16x32_bf16(Bt[n][k], At[m][k], acc[ai][bj][m][n], 0, 0, 0); __builtin_amdgcn_s_setprio(0); } while (0)
#define PG8_WAIT_V(n) asm volatile("s_waitcnt vmcnt(" #n ")" ::: "memory")
#define PG8_WAIT_L(n) asm volatile("s_waitcnt lgkmcnt(" #n ")" ::: "memory")
#define PG8_BAR __builtin_amdgcn_s_barrier()
#define PG8_SCHED __builtin_amdgcn_sched_barrier(0)
    Unit cur, nxt; int ui = 0;
    if (!S.next(0, cur)) return;
    f32x4 acc[2][2][4][2];
#pragma unroll
    for (int a = 0; a < 2; ++a)
#pragma unroll
        for (int b = 0; b < 2; ++b)
#pragma unroll
            for (int m = 0; m < 4; ++m)
#pragma unroll
                for (int n = 0; n < 2; ++n) acc[a][b][m][n] = (f32x4){0.f, 0.f, 0.f, 0.f};
    bf16x8 At[4][2], B0[2][2], B1[2][2];
    const char* cA = (const char*)g.A + (size_t)cur.pm * tstep; const char* cB = (const char*)g.Bt + (size_t)cur.pn * tstep;
    S.a_ready(cur);
    if constexpr (SP2) {
        PG8_STAGE(PG8_SB(0, 0), cB, voffB); PG8_STAGE(PG8_SB(0, 1), cB + hstep, voffB); PG8_STAGE(PG8_SA(0, 0), cA, voffA); PG8_STAGE(PG8_SA(0, 1), cA + hstep, voffA);
        if (wr == 1) PG8_BAR;
        PG8_WAIT_V(2); PG8_BAR;
        PG8_STAGE(PG8_SB(1, 0), cB + kstep, voffB); PG8_STAGE(PG8_SA(1, 0), cA + kstep, voffA); PG8_STAGE(PG8_SB(1, 1), cB + hstep + kstep, voffB);
        PG8_WAIT_V(6); PG8_BAR;
    } else {
        PG8_STAGE(PG8_SB(0, 0), cB, voffB); PG8_STAGE(PG8_SA(0, 0), cA, voffA); PG8_STAGE(PG8_SB(0, 1), cB + hstep, voffB); PG8_STAGE(PG8_SA(0, 1), cA + hstep, voffA);
        if (wr == 1) PG8_BAR;
        PG8_WAIT_V(4); PG8_BAR;
        PG8_STAGE(PG8_SB(1, 0), cB + kstep, voffB); PG8_STAGE(PG8_SA(1, 0), cA + kstep, voffA); PG8_STAGE(PG8_SB(1, 1), cB + hstep + kstep, voffB);
        PG8_WAIT_V(6); PG8_BAR;
    }
    for (;;) {
        const bool has_next = S.next(ui + 1, nxt);
        const char* nA = has_next ? (const char*)g.A + (size_t)nxt.pm * tstep : cA; const char* nB = has_next ? (const char*)g.Bt + (size_t)nxt.pn * tstep : cB;
        for (int t = 0; t < nt; t += 2) {
            const bool last = (t == nt - 2);
            const char* a1 = cA + (size_t)(t + 1) * kstep;
            const char* a2 = last ? nA : cA + (size_t)(t + 2) * kstep; const char* b2 = last ? nB : cB + (size_t)(t + 2) * kstep;
            const char* a3 = a2 + kstep; const char* b3 = b2 + kstep;
            if (last && has_next) S.a_ready(nxt);
            if constexpr (SP2) {
            PG8_LDB(B0, 0, 0); PG8_LDB(B1, 0, 1); PG8_SCHED; PG8_LDA(At, 0, 0); PG8_STAGE(PG8_SA(1, 1), a1 + hstep, voffA);
            PG8_WAIT_V(8); PG8_WAIT_L(0); PG8_BAR; PG8_MMA(0, 0, At, B0); PG8_MMA(0, 1, At, B1); PG8_BAR; PG8_SCHED;
            PG8_LDA(At, 0, 1); PG8_STAGE(PG8_SB(0, 0), b2, voffB); PG8_STAGE(PG8_SB(0, 1), b2 + hstep, voffB); PG8_STAGE(PG8_SA(0, 0), a2, voffA);
            PG8_WAIT_V(8); PG8_WAIT_L(0); PG8_BAR; PG8_MMA(1, 0, At, B0); PG8_MMA(1, 1, At, B1); PG8_BAR; PG8_SCHED;
            PG8_LDB(B0, 1, 0); PG8_LDB(B1, 1, 1); PG8_SCHED; PG8_LDA(At, 1, 0); PG8_STAGE(PG8_SA(0, 1), a2 + hstep, voffA);
            PG8_WAIT_V(8); PG8_WAIT_L(0); PG8_BAR; PG8_MMA(0, 0, At, B0); PG8_MMA(0, 1, At, B1); PG8_BAR; PG8_SCHED;
            PG8_LDA(At, 1, 1); PG8_STAGE(PG8_SB(1, 0), b3, voffB); PG8_STAGE(PG8_SB(1, 1), b3 + hstep, voffB); PG8_STAGE(PG8_SA(1, 0), a3, voffA);
            PG8_WAIT_V(8); PG8_WAIT_L(0); PG8_BAR; PG8_MMA(1, 0, At, B0); PG8_MMA(1, 1, At, B1); PG8_BAR; PG8_SCHED;
            } else {
            PG8_LDB(B0, 0, 0); PG8_SCHED; PG8_LDA(At, 0, 0); PG8_STAGE(PG8_SA(1, 1), a1 + hstep, voffA);
            PG8_WAIT_L(8); PG8_BAR; PG8_WAIT_L(0); PG8_MMA(0, 0, At, B0); PG8_BAR; PG8_SCHED;
            PG8_LDB(B1, 0, 1); PG8_STAGE(PG8_SB(0, 0), b2, voffB);
            PG8_BAR; PG8_WAIT_L(0); PG8_MMA(0, 1, At, B1); PG8_BAR;
            PG8_LDA(At, 0, 1); PG8_STAGE(PG8_SA(0, 0), a2, voffA);
            PG8_BAR; PG8_WAIT_L(0); PG8_MMA(1, 0, At, B0); PG8_BAR; PG8_SCHED;
            PG8_STAGE(PG8_SB(0, 1), b2 + hstep, voffB);
            PG8_WAIT_V(6); PG8_BAR; PG8_MMA(1, 1, At, B1); PG8_BAR;
            PG8_LDB(B0, 1, 0); PG8_SCHED; PG8_LDA(At, 1, 0); PG8_STAGE(PG8_SA(0, 1), a2 + hstep, voffA);
            PG8_WAIT_L(8); PG8_BAR; PG8_WAIT_L(0); PG8_MMA(0, 0, At, B0); PG8_BAR; PG8_SCHED;
            PG8_LDB(B1, 1, 1); PG8_STAGE(PG8_SB(1, 0), b3, voffB);
            PG8_BAR; PG8_WAIT_L(0); PG8_MMA(0, 1, At, B1); PG8_BAR;
            PG8_LDA(At, 1, 1); PG8_STAGE(PG8_SA(1, 0), a3, voffA);
            PG8_BAR; PG8_WAIT_L(0); PG8_MMA(1, 0, At, B0); PG8_BAR; PG8_SCHED;
            PG8_STAGE(PG8_SB(1, 1), b3 + hstep, voffB);
            PG8_WAIT_V(6); PG8_BAR; PG8_MMA(1, 1, At, B1); PG8_BAR;
            }
        }
        if constexpr (ALIGN_EPI) { if (wr == 0) PG8_BAR; }
        if constexpr (!Epi::AFTER_DRAIN) { E(acc, cur, wr, wc, fr, fq); S.done(cur); }
        if (!has_next) break;
#pragma unroll
        for (int a = 0; a < 2; ++a)
#pragma unroll
            for (int b = 0; b < 2; ++b)
#pragma unroll
                for (int m = 0; m < 4; ++m)
#pragma unroll
                    for (int n = 0; n < 2; ++n) acc[a][b][m][n] = (f32x4){0.f, 0.f, 0.f, 0.f};
        cur = nxt; cA = nA; cB = nB; ++ui;
        if constexpr (ALIGN_EPI) { if (wr == 1) PG8_BAR; }
    }
    PG8_WAIT_V(0);
    if constexpr (!ALIGN_EPI) { if (wr == 0) PG8_BAR; }
    PG8_BAR;
    if constexpr (Epi::AFTER_DRAIN) { E.fused(acc, cur, wr, wc, fr, fq, lds, wid, lane); S.done(cur); }
#undef PG8_SA
#undef PG8_SB
#undef PG8_STAGE
#undef PG8_LDA
#undef PG8_LDB
#undef PG8_MMA
#undef PG8_WAIT_V
#undef PG8_WAIT_L
#undef PG8_BAR
#undef PG8_SCHED
}
}

constexpr int D = 2048, NH = 16, HD = 128, NP = 8192, DEPTH = 4;
constexpr int BP = 4, TP = 4096, MP = BP * TP;
constexpr int BS = 16, TS = 32, MS = BS * TS, PAST = 2048;
constexpr int M = MP + MS;
constexpr float EPS = 1e-6f;
constexpr float LOG2E = 1.4426950408889634f;
constexpr float QSCALE = 0.08838834764831845f * LOG2E;
constexpr float SB_EXIT_LIN = 1e-24f;
constexpr size_t O_YP = 0, O_YS = O_YP + (size_t)MP * D, O_KP = O_YS + (size_t)MS * D, O_VP = O_KP + 2 * (size_t)MP * D, O_SP = O_VP + 2 * (size_t)MP * D,
                 O_KS = O_SP + 2 * (size_t)BP * NH * HD * HD, O_VS = O_KS + 2 * (size_t)MS * D, O_SS = O_VS + 2 * (size_t)MS * D, O_END = O_SS + 2 * (size_t)BS * NH * HD * HD;
static_assert(O_END == 183500800ull, "output size");
constexpr size_t MiB = 1u << 20;
constexpr size_t WS_CTL = 0, CTL_BYTES = 1 * MiB;
constexpr size_t WS_WIN = 1 * MiB;
constexpr size_t WS_WOUT = 129 * MiB;
constexpr size_t WS_XB = 161 * MiB;
constexpr size_t WS_SSQ = 227 * MiB;
constexpr size_t WS_OML = WS_SSQ + 768 * 1024;
constexpr size_t WS_QB = 228 * MiB, WS_KB = 294 * MiB, WS_VB = 360 * MiB, WS_GB = 426 * MiB;
constexpr size_t WS_LF = 492 * MiB;
constexpr size_t WS_OG = 624 * MiB;
constexpr size_t WS_HL = 690 * MiB;
constexpr size_t WS_END = 706 * MiB;

#define LAS __attribute__((address_space(3)))
typedef unsigned short bf16;
typedef float f32x4 __attribute__((ext_vector_type(4)));
typedef float f32x2 __attribute__((ext_vector_type(2)));
typedef unsigned u32x4 __attribute__((ext_vector_type(4)));
typedef unsigned u32x2 __attribute__((ext_vector_type(2)));
__device__ __forceinline__ float bf2f(unsigned short b) { return __uint_as_float(((unsigned)b) << 16); }
__device__ __forceinline__ float bflo(unsigned w) { return __uint_as_float(w << 16); }
__device__ __forceinline__ float bfhi(unsigned w) { return __uint_as_float(w & 0xffff0000u); }
__device__ __forceinline__ unsigned f2bf(float f) { unsigned u = __float_as_uint(f); return (u + 0x7fffu + ((u >> 16) & 1u)) >> 16; }
__device__ __forceinline__ unsigned pk2(float lo, float hi) { return f2bf(lo) | (f2bf(hi) << 16); }
__device__ __forceinline__ float wave_sum(float v) {
#pragma unroll
    for (int o = 1; o < 64; o <<= 1) v += __shfl_xor(v, o);
    return v;
}
__device__ __forceinline__ float silu_f(float x) { return x / (1.0f + __expf(-x)); }

#define WG_BAR() do { asm volatile("s_waitcnt lgkmcnt(0)" ::: "memory"); __builtin_amdgcn_s_barrier(); asm volatile("" ::: "memory"); } while (0)
struct Args { const float* in[12]; float* out; unsigned char* ws; };

__device__ __forceinline__ float row_rstd(const float* ssq, int row) {
    const f32x4 a = *(const f32x4*)(ssq + (size_t)row * 8), b = *(const f32x4*)(ssq + (size_t)row * 8 + 4);
    const float s = ((a.x + a.y) + (a.z + a.w)) + ((b.x + b.y) + (b.z + b.w));
    return rsqrtf(s * (1.0f / D) + EPS);
}
__device__ __forceinline__ float hgrn_lower_bound(const float* hgrn_lb, int j, int c) {
    if (j == 0) return 0.0f;
    const float l0 = hgrn_lb[c], l1 = hgrn_lb[D + c], mx = fmaxf(l0, l1), e0 = __expf(l0 - mx), e1 = __expf(l1 - mx);
    return fminf(fmaxf(e1 / (e0 + e1), 0.0f), 1.0f - 1e-6f);
}

constexpr int RING_BYTES = 131072;
constexpr int LDSCTL_OFF = RING_BYTES;
constexpr int EPI_OFF = LDSCTL_OFF + 1024;
constexpr int LDS_BYTES = 147456;
static_assert(EPI_OFF + 8192 <= LDS_BYTES, "LDS map");
#define XB_TMO      128
#define XB_XCNT(j)  (256  + 64 * (j))
#define XB_XSUB(j)  (1280 + 64 * (j))
#define XB_XGEN(j)  (2304 + 64 * (j))
#define XB_TOP      3328
#define XB_TOPGEN   3392
#define XCD_BAR_WORDS 3456
#define XB_SPIN_CAP (1u << 18)

__device__ __forceinline__ unsigned xb_ld(unsigned* p)              { return __hip_atomic_load(p, __ATOMIC_RELAXED, __HIP_MEMORY_SCOPE_AGENT); }
__device__ __forceinline__ unsigned xb_add(unsigned* p, unsigned v) { return __hip_atomic_fetch_add(p, v, __ATOMIC_RELAXED, __HIP_MEMORY_SCOPE_AGENT); }
__device__ __forceinline__ unsigned xb_xcc_id() { return (unsigned)__builtin_amdgcn_s_getreg((3 << 11) | 20) & 0xFu; }
#define XB_SPIN(cond, bar) do { unsigned _sp = 0; while (cond) { __builtin_amdgcn_s_sleep(1); \
    if ((++_sp & 255u) == 0u) { if (xb_ld(&(bar)[XB_TMO])) break; if (_sp > XB_SPIN_CAP) { atomicAdd(&(bar)[XB_TMO], 1u); break; } } } } while (0)

struct XcdBarrier {
    unsigned* bar; unsigned x;
    volatile LAS unsigned* st;
};

__device__ __forceinline__ XcdBarrier xcd_barrier_post(unsigned* bar, volatile LAS unsigned* st) {
    XcdBarrier b; b.bar = bar; b.x = xb_xcc_id(); b.st = st;
    if (threadIdx.x == 0) (void)xb_add(&bar[XB_XCNT(b.x)], 1u);
    return b;
}
__device__ __forceinline__ void xcd_barrier_complete(unsigned* bar, unsigned x, unsigned& nloc, unsigned& nx) {
    const unsigned G = gridDim.x * gridDim.y * gridDim.z;
    unsigned sum, cnt, mine, sp = 0u;
    for (;;) {
        sum = 0u; cnt = 0u; mine = 0u;
#pragma unroll
        for (unsigned j = 0; j < 16; ++j) { const unsigned c = xb_ld(&bar[XB_XCNT(j)]); sum += c; cnt += (c > 0u) ? 1u : 0u; mine = (j == x) ? c : mine; }
        if (sum == G) break;
        __builtin_amdgcn_s_sleep(1);
        if ((++sp & 255u) == 0u) { if (xb_ld(&bar[XB_TMO])) break; if (sp > XB_SPIN_CAP) { atomicAdd(&bar[XB_TMO], 1u); break; } }
    }
    nloc = mine > 0u ? mine : 1u; nx = cnt > 0u ? cnt : 1u;
}

__device__ __forceinline__ void xcd_barrier(const XcdBarrier& b) {
    asm volatile("s_waitcnt vmcnt(0)" ::: "memory");
    __syncthreads();
    if (threadIdx.x == 0) {
        unsigned* bar = b.bar;
        __builtin_amdgcn_s_waitcnt(0);
        unsigned nloc = b.st[0], nx = b.st[1];
        if (nloc == 0u) { xcd_barrier_complete(bar, b.x, nloc, nx); b.st[0] = nloc; b.st[1] = nx; }
        const unsigned old = xb_add(&bar[XB_XSUB(b.x)], 1u);
        const unsigned gen = old / nloc;
        if (old + 1u == (gen + 1u) * nloc) {
            __builtin_amdgcn_fence(__ATOMIC_RELEASE, "agent");
            asm volatile("s_waitcnt vmcnt(0)" ::: "memory");
            const unsigned og = xb_add(&bar[XB_TOP], 1u);
            const unsigned tg = og / nx;
            if (og + 1u == (tg + 1u) * nx) xb_add(&bar[XB_TOPGEN], 1u);
            else XB_SPIN(xb_ld(&bar[XB_TOPGEN]) == tg, bar);
            __builtin_amdgcn_fence(__ATOMIC_ACQUIRE, "agent");
            xb_add(&bar[XB_XGEN(b.x)], 1u);
            asm volatile("s_waitcnt vmcnt(0)" ::: "memory");
        } else {
            XB_SPIN(xb_ld(&bar[XB_XGEN(b.x)]) == gen, bar);
            __builtin_amdgcn_fence(__ATOMIC_ACQUIRE, "agent");
            asm volatile("s_waitcnt vmcnt(0)" ::: "memory");
        }
    }
    __syncthreads();
}
__device__ __forceinline__ void transpose_item(const float* W, const float* kscale, int K, int N, bf16* WT, unsigned char* scr, int item, int lane) {
    const int nblk = N / 64, kb = item / nblk, nb = item % nblk, k0 = 64 * kb, n0 = 64 * nb, ks = lane >> 4, n4 = (lane & 15) * 4;
    f32x4 v[16];
#pragma unroll
    for (int i = 0; i < 8; ++i) { const float* src = W + (size_t)(k0 + 8 * i + 2 * ks) * N + n0 + n4; v[2 * i] = *(const f32x4*)src; v[2 * i + 1] = *(const f32x4*)(src + N); }
    f32x2 sc[8];
#pragma unroll
    for (int i = 0; i < 8; ++i) { if (kscale) sc[i] = *(const f32x2*)(kscale + k0 + 8 * i + 2 * ks); else sc[i] = (f32x2){1.f, 1.f}; }
#pragma unroll
    for (int i = 0; i < 8; ++i)
#pragma unroll
        for (int e = 0; e < 4; ++e) *(unsigned*)(scr + (n4 + e) * 132 + 16 * i + 4 * ks) = pg8::cvt_pk_bf16(v[2 * i][e] * sc[i].x, v[2 * i + 1][e] * sc[i].y);
    __builtin_amdgcn_s_waitcnt(0xc07f); asm volatile("" ::: "memory");
    const int c = lane & 7;
#pragma unroll
    for (int ps = 0; ps < 8; ++ps) { const int n = (lane >> 3) + 8 * ps; const unsigned char* s = scr + n * 132 + 16 * c;
        u32x4 o; o.x = *(const unsigned*)s; o.y = *(const unsigned*)(s + 4); o.z = *(const unsigned*)(s + 8); o.w = *(const unsigned*)(s + 12);
        *(u32x4*)(WT + (size_t)(n0 + n) * K + k0 + 8 * c) = o; }
    __builtin_amdgcn_s_waitcnt(0xc07f); asm volatile("" ::: "memory");
}
__device__ __forceinline__ void convert_layer_weights(const Args& a, unsigned char* scr, int l, int gw, int ngw, int lane) {
    const float* norm_w = a.in[5]; const float* w_in = a.in[6]; const float* w_out = a.in[7];
    bf16* WinT = (bf16*)(a.ws + WS_WIN); bf16* WoutT = (bf16*)(a.ws + WS_WOUT);
    constexpr int I_IN = (D / 64) * (NP / 64), I_OUT = (D / 64) * (D / 64);
    for (int r = gw; r < I_IN + I_OUT; r += ngw) {
        if (r < I_IN) transpose_item(w_in + (size_t)l * D * NP, norm_w + l * D, D, NP, WinT + (size_t)l * NP * D, scr, r, lane);
        else transpose_item(w_out + (size_t)l * D * D, nullptr, D, D, WoutT + (size_t)l * D * D, scr, r - I_IN, lane);
    }
}
__device__ __forceinline__ void prologue_phase(const Args& a, unsigned char* shm, int bid, int nblk) {
    const int tid = fresh_tid(), lane = tid & 63, wave = tid >> 6;
    unsigned char* scr = shm + wave * (64 * 132);
    const int gw = bid * 8 + wave, NGW = nblk * 8;
    convert_layer_weights(a, scr, 0, gw, NGW, lane);
    if (bid == 0) { float* oml = (float*)(a.ws + WS_OML); for (int c = tid; c < 2 * D; c += 512) oml[c] = 1.0f - hgrn_lower_bound(a.in[11], c / D, c % D); }
    bf16* XB = (bf16*)(a.ws + WS_XB); float* ssq = (float*)(a.ws + WS_SSQ);
    for (int row = gw; row < M; row += NGW) {
        const float* src = row < MP ? a.in[0] + (size_t)row * D : a.in[1] + (size_t)(row - MP) * D;
        float s = 0.f;
#pragma unroll
        for (int j = 0; j < 8; ++j) { const f32x4 v = *(const f32x4*)(src + 4 * (lane + 64 * j)); s += (v.x * v.x + v.y * v.y) + (v.z * v.z + v.w * v.w);
            u32x2 o; o.x = pg8::cvt_pk_bf16(v.x, v.y); o.y = pg8::cvt_pk_bf16(v.z, v.w); *(u32x2*)(XB + (size_t)row * D + 4 * (lane + 64 * j)) = o; }
        s = wave_sum(s);
        if (lane < 8) ssq[(size_t)row * 8 + lane] = lane == 0 ? s : 0.f;
    }
}


namespace att {
using bf16x8 = __attribute__((ext_vector_type(8))) short;
using s16x4  = __attribute__((ext_vector_type(4))) short;
using f32x16 = __attribute__((ext_vector_type(16))) float;
constexpr int SHM_T = 64 * 128 * 2;
#define ATT_KSWZ(row, colB) ((row) * 256 + ((colB) ^ (((row) & 7) << 4)))
__device__ __forceinline__ int crow(int r, int hi) { return (r & 3) + 8 * (r >> 2) + 4 * hi; }
__device__ __forceinline__ unsigned cvtpk(float lo, float hi) { unsigned r; asm volatile("v_cvt_pk_bf16_f32 %0, %1, %2" : "=v"(r) : "v"(lo), "v"(hi)); return r; }
__device__ __forceinline__ int v_st(int k, int c) { const int kk = (k & ~0xC) | ((k & 4) << 1) | ((k & 8) >> 1); return ((kk >> 3) * 4 + (c >> 5)) * 512 + ((kk & 7) * 32 + (c & 31)) * 2; }
__device__ __forceinline__ int v_rd_base(int lane) { return ((lane & 3) << 3) | (((lane >> 2) & 3) << 6) | (((lane >> 4) & 1) << 5) | (((lane >> 5) & 1) << 8); }
constexpr int v_rd_off(int d0, int ks, int half) { return d0 * 512 + ks * 4096 + half * 2048; }
template <int OFF> __device__ __forceinline__ s16x4 tr_read(int vb) { s16x4 r; asm volatile("ds_read_b64_tr_b16 %0, %1 offset:%2" : "=&v"(r) : "v"(vb), "i"(OFF) : "memory"); return r; }
__device__ __forceinline__ void qkt(f32x16& p0, f32x16& p1, const char* Ks, const bf16x8* qr, int r32, int hi) {
    p0 = f32x16{}; p1 = f32x16{};
#pragma unroll
    for (int d0 = 0; d0 < 8; ++d0) { const int cb = (d0 * 16 + hi * 8) * 2;
        const bf16x8 b0 = *reinterpret_cast<const bf16x8*>(Ks + ATT_KSWZ(r32, cb));
        const bf16x8 b1 = *reinterpret_cast<const bf16x8*>(Ks + ATT_KSWZ(32 + r32, cb));
        p0 = __builtin_amdgcn_mfma_f32_32x32x16_bf16(b0, qr[d0], p0, 0, 0, 0);
        p1 = __builtin_amdgcn_mfma_f32_32x32x16_bf16(b1, qr[d0], p1, 0, 0, 0); }
}
template <int D0> __device__ __forceinline__ void pv_one(f32x16& od, int vb, bf16x8 pa0, bf16x8 pa1, bf16x8 pa2, bf16x8 pa3) {
    const s16x4 l0 = tr_read<v_rd_off(D0, 0, 0)>(vb), h0 = tr_read<v_rd_off(D0, 0, 1)>(vb), l1 = tr_read<v_rd_off(D0, 1, 0)>(vb), h1 = tr_read<v_rd_off(D0, 1, 1)>(vb);
    const s16x4 l2 = tr_read<v_rd_off(D0, 2, 0)>(vb), h2 = tr_read<v_rd_off(D0, 2, 1)>(vb), l3 = tr_read<v_rd_off(D0, 3, 0)>(vb), h3 = tr_read<v_rd_off(D0, 3, 1)>(vb);
    asm volatile("s_waitcnt lgkmcnt(0)" ::: "memory"); __builtin_amdgcn_sched_barrier(0);
#define ATT_PK(L, H) (bf16x8){L[0], L[1], L[2], L[3], H[0], H[1], H[2], H[3]}
    od = __builtin_amdgcn_mfma_f32_32x32x16_bf16(ATT_PK(l0, h0), pa0, od, 0, 0, 0);
    od = __builtin_amdgcn_mfma_f32_32x32x16_bf16(ATT_PK(l1, h1), pa1, od, 0, 0, 0);
    od = __builtin_amdgcn_mfma_f32_32x32x16_bf16(ATT_PK(l2, h2), pa2, od, 0, 0, 0);
    od = __builtin_amdgcn_mfma_f32_32x32x16_bf16(ATT_PK(l3, h3), pa3, od, 0, 0, 0);
#undef ATT_PK
}
template <bool CHECK_NEG, bool MASK> __device__ __forceinline__ float sb_half(f32x16& p, float C, int kpos0, int qpos, int hi) {
    float om[16];
#pragma unroll
    for (int r = 0; r < 16; ++r) { const float e = __builtin_amdgcn_exp2f(fminf(p[r], 80.f)), q = __builtin_amdgcn_rcpf(1.0f + e); float be = e * q, o1 = q;
        if (MASK) { const int pos = kpos0 + crow(r, hi); const bool valid = (pos < qpos) && (!CHECK_NEG || pos >= 0); be = valid ? be : 0.f; o1 = valid ? o1 : 1.f; }
        p[r] = be; om[r] = o1; }
    float s[4], ex[4];
#pragma unroll
    for (int g = 0; g < 4; ++g) {
        const float o0 = om[4 * g], o1 = om[4 * g + 1], o2 = om[4 * g + 2], o3 = om[4 * g + 3];
        const float e2 = o3, e1 = e2 * o2, e0 = e1 * o1, tt = e0 * o0;
        om[4 * g + 3] = 1.f; om[4 * g + 2] = e2; om[4 * g + 1] = e1; om[4 * g] = e0;
        const auto rr = __builtin_amdgcn_permlane32_swap(__float_as_uint(tt), __float_as_uint(tt), false, false);
        s[g] = __uint_as_float(rr[0]) * __uint_as_float(rr[1]); ex[g] = hi ? 1.f : __uint_as_float(rr[1]); }
    float base[4];
    base[3] = C; base[2] = base[3] * s[3]; base[1] = base[2] * s[2]; base[0] = base[1] * s[1];
    const float Cn = base[0] * s[0];
#pragma unroll
    for (int g = 0; g < 4; ++g) { const float bg = base[g] * ex[g];
        p[4 * g + 3] *= bg; p[4 * g + 2] *= om[4 * g + 2] * bg; p[4 * g + 1] *= om[4 * g + 1] * bg; p[4 * g] *= om[4 * g] * bg; }
    return Cn;
}
#define ATT_PK4(P, BASE, OUT) do { const unsigned a0_ = cvtpk(P[BASE + 0], P[BASE + 1]), a1_ = cvtpk(P[BASE + 2], P[BASE + 3]); \
    const unsigned b0_ = cvtpk(P[BASE + 4], P[BASE + 5]), b1_ = cvtpk(P[BASE + 6], P[BASE + 7]); \
    const auto r0_ = __builtin_amdgcn_permlane32_swap(a0_, b0_, false, false); const auto r1_ = __builtin_amdgcn_permlane32_swap(a1_, b1_, false, false); \
    u32x4 w_ = {r0_[0], r1_[0], r0_[1], r1_[1]}; OUT = *reinterpret_cast<bf16x8*>(&w_); } while (0)

struct Stg { bf16x8 k0, k1, v0, v1; };
__device__ __forceinline__ bf16x8 cvt8(const float* p) { const f32x4 x = *(const f32x4*)p, y = *(const f32x4*)(p + 4); u32x4 w = {cvtpk(x.x, x.y), cvtpk(x.z, x.w), cvtpk(y.x, y.y), cvtpk(y.z, y.w)}; return *reinterpret_cast<bf16x8*>(&w); }
template <bool SAMPLE> __device__ __forceinline__ void load_kv(const Args& a, int j, int b, int h, int pb, int sr, int sc, Stg& st) {
    const bf16* KB = (const bf16*)(a.ws + WS_KB); const bf16* VB = (const bf16*)(a.ws + WS_VB);
    if constexpr (!SAMPLE) {
        const size_t o0 = (size_t)(b * TP + pb + sr) * D + h * HD + sc, o1 = o0 + (size_t)32 * D;
        st.k0 = *(const bf16x8*)(KB + o0); st.k1 = *(const bf16x8*)(KB + o1); st.v0 = *(const bf16x8*)(VB + o0); st.v1 = *(const bf16x8*)(VB + o1);
    } else {
        const float* ck = a.in[2] + ((size_t)(j * BS + b) * PAST) * D + h * HD + sc; const float* cv = a.in[3] + ((size_t)(j * BS + b) * PAST) * D + h * HD + sc;
        const bf16x8 zero = {0, 0, 0, 0, 0, 0, 0, 0};
        const int p0 = pb + sr, p1 = pb + 32 + sr;
        if (p0 >= PAST) { const size_t o = (size_t)(MP + b * TS + (p0 - PAST)) * D + h * HD + sc; st.k0 = *(const bf16x8*)(KB + o); st.v0 = *(const bf16x8*)(VB + o); }
        else if (p0 >= 0) { st.k0 = cvt8(ck + (size_t)p0 * D); st.v0 = cvt8(cv + (size_t)p0 * D); }
        else { st.k0 = zero; st.v0 = zero; }
        if (p1 >= PAST) { const size_t o = (size_t)(MP + b * TS + (p1 - PAST)) * D + h * HD + sc; st.k1 = *(const bf16x8*)(KB + o); st.v1 = *(const bf16x8*)(VB + o); }
        else if (p1 >= 0) { st.k1 = cvt8(ck + (size_t)p1 * D); st.v1 = cvt8(cv + (size_t)p1 * D); }
        else { st.k1 = zero; st.v1 = zero; }
    }
}
__device__ __forceinline__ void write_kv(char* V_lds, char* K_lds, int buf, int sr, int sc, const Stg& st) {
    *(bf16x8*)(V_lds + buf * SHM_T + v_st(sr, sc)) = st.v0; *(bf16x8*)(V_lds + buf * SHM_T + v_st(32 + sr, sc)) = st.v1;
    *(bf16x8*)(K_lds + buf * SHM_T + ATT_KSWZ(sr, sc * 2)) = st.k0; *(bf16x8*)(K_lds + buf * SHM_T + ATT_KSWZ(32 + sr, sc * 2)) = st.k1;
}
template <bool SAMPLE> __device__ __forceinline__ void attn_item(const Args& a, unsigned char* shm, int j, int b, int h, int q0) {
    const int tid = fresh_tid(), wid = __builtin_amdgcn_readfirstlane(tid >> 6), lane = tid & 63, r32 = lane & 31, hi = lane >> 5;
    char* V_lds = (char*)shm; char* K_lds = (char*)shm + 2 * SHM_T; volatile unsigned* flags = (volatile unsigned*)(shm + 4 * SHM_T);
    const bf16* QB = (const bf16*)(a.ws + WS_QB); const bf16* GB = (const bf16*)(a.ws + WS_GB); bf16* OG = (bf16*)(a.ws + WS_OG);
    const int qbw = SAMPLE ? PAST : q0 + 32 * wid;
    const int qpos = qbw + r32;
    const size_t qrow = SAMPLE ? (size_t)(MP + b * TS + r32) : (size_t)(b * TP + qpos);
    bool done = SAMPLE ? (wid != 0) : false;
    bf16x8 qr[8];
#pragma unroll
    for (int d0 = 0; d0 < 8; ++d0) qr[d0] = *(const bf16x8*)(QB + qrow * D + h * HD + d0 * 16 + hi * 8);
    f32x16 o[4] = {}; float C = 1.f;
    const int ptop = SAMPLE ? PAST - 32 : q0 + 192, ntiles = SAMPLE ? 33 : ptop / 64 + 1;
    const int sr = tid >> 4, sc = (tid & 15) * 8, vb0 = (int)(uintptr_t)V_lds + v_rd_base(lane);
    if (tid < 16) flags[tid] = 0u;
    Stg st; load_kv<SAMPLE>(a, j, b, h, ptop, sr, sc, st);
    write_kv(V_lds, K_lds, 0, sr, sc, st);
    if (ntiles > 1) load_kv<SAMPLE>(a, j, b, h, ptop - 64, sr, sc, st);
    WG_BAR();
    for (int ti = 0;; ++ti) {
        const int pb = ptop - 64 * ti, cur = ti & 1;
        if (!done && pb < qbw + 31) {
            f32x16 p0, p1;
            qkt(p0, p1, K_lds + cur * SHM_T, qr, r32, hi);
            if (pb + 63 < qbw && (!SAMPLE || pb >= 0)) { C = sb_half<SAMPLE, false>(p1, C, pb + 32, qpos, hi); C = sb_half<SAMPLE, false>(p0, C, pb, qpos, hi); }
            else { C = sb_half<SAMPLE, true>(p1, C, pb + 32, qpos, hi); C = sb_half<SAMPLE, true>(p0, C, pb, qpos, hi); }
            bf16x8 pa0, pa1, pa2, pa3;
            ATT_PK4(p0, 0, pa0); ATT_PK4(p0, 8, pa1); ATT_PK4(p1, 0, pa2); ATT_PK4(p1, 8, pa3);
            const int vb = vb0 + cur * SHM_T;
            pv_one<0>(o[0], vb, pa0, pa1, pa2, pa3); pv_one<1>(o[1], vb, pa0, pa1, pa2, pa3); pv_one<2>(o[2], vb, pa0, pa1, pa2, pa3); pv_one<3>(o[3], vb, pa0, pa1, pa2, pa3);
            done = __all(C < SB_EXIT_LIN);
        }
        const bool more = ti + 1 < ntiles;
        if (more) write_kv(V_lds, K_lds, cur ^ 1, sr, sc, st);
        if (ti + 2 < ntiles) load_kv<SAMPLE>(a, j, b, h, ptop - 64 * (ti + 2), sr, sc, st);
        if (lane == 0) flags[cur * 8 + wid] = done ? 1u : 0u;
        WG_BAR();
        if (!more) break;
        unsigned nd = 0;
#pragma unroll
        for (int w = 0; w < 8; ++w) nd += flags[cur * 8 + w];
        if (nd == 8u) break;
    }
    if (!SAMPLE || wid == 0) {
        float* ol = (float*)(shm + wid * 16384);
#pragma unroll
        for (int d0 = 0; d0 < 4; ++d0)
#pragma unroll
            for (int g = 0; g < 4; ++g) *(f32x4*)(ol + r32 * 128 + (((8 * d0 + 2 * g + hi) ^ r32) << 2)) = (f32x4){o[d0][4 * g + 0], o[d0][4 * g + 1], o[d0][4 * g + 2], o[d0][4 * g + 3]};
        asm volatile("s_waitcnt lgkmcnt(0)" ::: "memory");
        const size_t row0 = SAMPLE ? (size_t)(MP + b * TS) : (size_t)(b * TP + qbw);
#pragma unroll
        for (int i = 0; i < 8; ++i) { const int q = 4 * i + (lane >> 4), c = (lane & 15) * 8; const size_t idx = (row0 + q) * D + h * HD + c;
            const u32x4 gt = *(const u32x4*)(GB + idx); const f32x4 x0 = *(const f32x4*)(ol + q * 128 + ((((c >> 2)) ^ q) << 2)), x1 = *(const f32x4*)(ol + q * 128 + ((((c >> 2) + 1) ^ q) << 2));
            u32x4 w; w.x = cvtpk(x0.x * bflo(gt.x), x0.y * bfhi(gt.x)); w.y = cvtpk(x0.z * bflo(gt.y), x0.w * bfhi(gt.y)); w.z = cvtpk(x1.x * bflo(gt.z), x1.y * bfhi(gt.z)); w.w = cvtpk(x1.z * bflo(gt.w), x1.w * bfhi(gt.w));
            *(u32x4*)(OG + idx) = w; }
    }
    __syncthreads();
}
__device__ __forceinline__ void attn_item3(const Args& a, unsigned char* shm, int j, int b, int h, int q0) {
    const int tid = fresh_tid(), wid = __builtin_amdgcn_readfirstlane(tid >> 6), lane = tid & 63, r32 = lane & 31, hi = lane >> 5;
    volatile unsigned* flags = (volatile unsigned*)(shm + 6 * SHM_T);
    const bf16* QB = (const bf16*)(a.ws + WS_QB); const bf16* GB = (const bf16*)(a.ws + WS_GB); bf16* OG = (bf16*)(a.ws + WS_OG);
    const int qbw = q0 + 32 * wid, qpos = qbw + r32;
    const size_t qrow = (size_t)(b * TP + qpos);
    bool done = false;
    bf16x8 qr[8];
#pragma unroll
    for (int d0 = 0; d0 < 8; ++d0) qr[d0] = *(const bf16x8*)(QB + qrow * D + h * HD + d0 * 16 + hi * 8);
    f32x16 o[4] = {}; float C = 1.f;
    const int ptop = q0 + 192, ntiles = ptop / 64 + 1;
    const int vbl = (int)(uintptr_t)shm + v_rd_base(lane);
    if (tid < 16) flags[tid] = 0u;
    const bool isK = wid >= 4; const int cb0 = 4 * (wid & 3);
    unsigned offs[4];
#pragma unroll
    for (int i = 0; i < 4; ++i) { const int cb = cb0 + i; int row, col;
        if (isK) { row = cb * 4 + (lane >> 4); const int colB = ((lane & 15) * 16) ^ ((row & 7) << 4); col = colB >> 1; }
        else { const int sb = cb * 2 + (lane >> 5), kk = (sb >> 2) * 8 + ((lane & 31) >> 2); row = (kk & ~0xC) | ((kk & 4) << 1) | ((kk & 8) >> 1); col = (sb & 3) * 32 + (lane & 3) * 8; }
        offs[i] = (unsigned)(row * D + col); }
    const bf16* src0 = (isK ? (const bf16*)(a.ws + WS_KB) : (const bf16*)(a.ws + WS_VB)) + (size_t)(b * TP) * D + h * HD;
    unsigned char* dst0 = shm + (isK ? SHM_T : 0) + cb0 * 1024;
#define ATT_DMA(slot, pb_) do { const bf16* s_ = src0 + (size_t)(pb_) * D; LAS unsigned* d_ = (LAS unsigned*)(LAS unsigned char*)(dst0 + (slot) * 2 * SHM_T); \
        _Pragma("unroll") for (int i_ = 0; i_ < 4; ++i_) __builtin_amdgcn_global_load_lds((const unsigned*)(s_ + offs[i_]), d_ + i_ * 256, 16, 0, 0); } while (0)
    ATT_DMA(0, ptop);
    if (ntiles > 1) ATT_DMA(1, ptop - 64);
    int s = 0;
    for (int ti = 0; ti < ntiles; ++ti) {
        const int pb = ptop - 64 * ti;
        if (ti + 1 < ntiles) asm volatile("s_waitcnt vmcnt(4)" ::: "memory"); else asm volatile("s_waitcnt vmcnt(0)" ::: "memory");
        WG_BAR();
        if (ti > 0) { unsigned nd = 0;
#pragma unroll
            for (int w = 0; w < 8; ++w) nd += flags[((ti - 1) & 1) * 8 + w];
            if (nd == 8u) break; }
        if (ti + 2 < ntiles) { const int s2 = s >= 1 ? s - 1 : 2; ATT_DMA(s2, pb - 128); }
        if (!done && pb < qbw + 31) {
            f32x16 p0, p1;
            qkt(p0, p1, (const char*)shm + (2 * s + 1) * SHM_T, qr, r32, hi);
            if (pb + 63 < qbw) { C = sb_half<false, false>(p1, C, pb + 32, qpos, hi); C = sb_half<false, false>(p0, C, pb, qpos, hi); }
            else { C = sb_half<false, true>(p1, C, pb + 32, qpos, hi); C = sb_half<false, true>(p0, C, pb, qpos, hi); }
            bf16x8 pa0, pa1, pa2, pa3;
            ATT_PK4(p0, 0, pa0); ATT_PK4(p0, 8, pa1); ATT_PK4(p1, 0, pa2); ATT_PK4(p1, 8, pa3);
            const int vb = vbl + 2 * s * SHM_T;
            pv_one<0>(o[0], vb, pa0, pa1, pa2, pa3); pv_one<1>(o[1], vb, pa0, pa1, pa2, pa3); pv_one<2>(o[2], vb, pa0, pa1, pa2, pa3); pv_one<3>(o[3], vb, pa0, pa1, pa2, pa3);
            done = __all(C < SB_EXIT_LIN);
        }
        if (lane == 0) flags[(ti & 1) * 8 + wid] = done ? 1u : 0u;
        s = s == 2 ? 0 : s + 1;
    }
#undef ATT_DMA
    asm volatile("s_waitcnt vmcnt(0)" ::: "memory");
    WG_BAR();
    {
        float* ol = (float*)(shm + wid * 16384);
#pragma unroll
        for (int d0 = 0; d0 < 4; ++d0)
#pragma unroll
            for (int g = 0; g < 4; ++g) *(f32x4*)(ol + r32 * 128 + (((8 * d0 + 2 * g + hi) ^ r32) << 2)) = (f32x4){o[d0][4 * g + 0], o[d0][4 * g + 1], o[d0][4 * g + 2], o[d0][4 * g + 3]};
        asm volatile("s_waitcnt lgkmcnt(0)" ::: "memory");
        const size_t row0 = (size_t)(b * TP + qbw);
#pragma unroll
        for (int i = 0; i < 8; ++i) { const int q = 4 * i + (lane >> 4), c = (lane & 15) * 8; const size_t idx = (row0 + q) * D + h * HD + c;
            const u32x4 gt = *(const u32x4*)(GB + idx); const f32x4 x0 = *(const f32x4*)(ol + q * 128 + ((((c >> 2)) ^ q) << 2)), x1 = *(const f32x4*)(ol + q * 128 + ((((c >> 2) + 1) ^ q) << 2));
            u32x4 w; w.x = cvtpk(x0.x * bflo(gt.x), x0.y * bfhi(gt.x)); w.y = cvtpk(x0.z * bflo(gt.y), x0.w * bfhi(gt.y)); w.z = cvtpk(x1.x * bflo(gt.z), x1.y * bfhi(gt.z)); w.w = cvtpk(x1.z * bflo(gt.w), x1.w * bfhi(gt.w));
            *(u32x4*)(OG + idx) = w; }
    }
    __syncthreads();
}
}
__device__ __forceinline__ void ph_attn(const Args& a, unsigned char* shm, int bid, int nblk, int layer) {
    const int j = layer >> 1;
    for (int it = bid; it < BP * NH * (TP / 256) + BS * NH; it += nblk) {
        if (it < BP * NH * (TP / 256)) att::attn_item3(a, shm, j, it >> 8, (it >> 4) & 15, (it & 15) * 256);
        else { const int u = it - BP * NH * (TP / 256); att::attn_item<true>(a, shm, j, u >> 4, u & 15, 0); }
    }
}


namespace hg {
using bf16x8 = __attribute__((ext_vector_type(8))) short;
using s16x4  = __attribute__((ext_vector_type(4))) short;
constexpr int T_QH = 0, T_KD = 8192, T_KT = 16384, T_V = 24576, T_TOT = 32768, T_DEC = T_TOT + 8 * 128 * 4, BUFSZ = T_DEC + 512, T_P = 2 * BUFSZ, PST = 80, T_O = T_P + 32 * PST, OST = 132, T_END = T_O + 32 * OST * 4;
static_assert(BUFSZ % 16 == 0 && T_P % 16 == 0 && T_O % 16 == 0 && T_END <= 131072, "hgrn LDS map");
constexpr int SEG = 1024, NSEG = TP / SEG;
constexpr size_t HL_DG = (size_t)BP * NH * (NSEG - 1) * HD * HD * 4;
__device__ __forceinline__ unsigned off_b(unsigned row, unsigned ch) { return 256u * row + 16u * (ch ^ (((row & 3) << 2) | ((row >> 2) & 3))); }
__device__ __forceinline__ unsigned row_read_addr_16(unsigned lane, unsigned rb, unsigned s) { return off_b((lane & 15) + 16 * rb, 4 * s + (lane >> 4)); }
__device__ __forceinline__ unsigned tr_read_addr_16(unsigned lane, unsigned c, unsigned t) {
    const unsigned g = lane >> 4, q = (lane & 15) >> 2, p = lane & 3; return off_b(8 * g + 4 * t + q, 2 * c + (p >> 1)) + 8 * (p & 1); }
__device__ __forceinline__ unsigned cvtpk(float lo, float hi) { unsigned r; asm volatile("v_cvt_pk_bf16_f32 %0, %1, %2" : "=v"(r) : "v"(lo), "v"(hi)); return r; }
__device__ __forceinline__ s16x4 tr_ld(unsigned addr) { s16x4 r; asm volatile("ds_read_b64_tr_b16 %0, %1" : "=&v"(r) : "v"(addr) : "memory"); return r; }
#define HG_LGKM0() do { asm volatile("s_waitcnt lgkmcnt(0)" ::: "memory"); __builtin_amdgcn_sched_barrier(0); } while (0)
#define HG_CAT(L, H) (bf16x8){L[0], L[1], L[2], L[3], H[0], H[1], H[2], H[3]}
__device__ __forceinline__ f32x4 mfma16(bf16x8 a, bf16x8 b, f32x4 c) { return __builtin_amdgcn_mfma_f32_16x16x32_bf16(a, b, c, 0, 0, 0); }

struct Pre { f32x2 l[4]; unsigned qv[4]; u32x4 vv, gv; };
template <bool FULL> __device__ __forceinline__ void load_chunk(const Args& a, int r0, int h, int tid, Pre& p) {
    const int lane = tid & 63, w = tid >> 6;
    const bf16* QB = (const bf16*)(a.ws + WS_QB); const bf16* VB = (const bf16*)(a.ws + WS_VB); const bf16* GB = (const bf16*)(a.ws + WS_GB); const float* LF = (const float*)(a.ws + WS_LF);
#pragma unroll
    for (int i = 0; i < 4; ++i) { const size_t idx = (size_t)(r0 + 4 * w + i) * D + h * HD + 2 * lane; p.l[i] = *(const f32x2*)(LF + idx); if (FULL) p.qv[i] = *(const unsigned*)(QB + idx); }
    const size_t vidx = (size_t)(r0 + (tid >> 4)) * D + h * HD + 8 * (tid & 15);
    p.vv = *(const u32x4*)(VB + vidx); if (FULL) p.gv = *(const u32x4*)(GB + vidx);
}
struct StA { f32x2 l[4], c[4]; unsigned qv[4]; };
template <bool FULL> __device__ __forceinline__ void stageA(unsigned char* bufp, int tid, const Pre& p, StA& sa, u32x4& gv) {
    const int lane = tid & 63, w = __builtin_amdgcn_readfirstlane(tid >> 6);
#pragma unroll
    for (int i = 0; i < 4; ++i) { sa.l[i] = p.l[i] * LOG2E; if (FULL) sa.qv[i] = p.qv[i]; }
    if (FULL) gv = p.gv;
    sa.c[0] = sa.l[0]; sa.c[1] = sa.c[0] + sa.l[1]; sa.c[2] = sa.c[1] + sa.l[2]; sa.c[3] = sa.c[2] + sa.l[3];
    *(f32x2*)(bufp + T_TOT + (w * 128 + 2 * lane) * 4) = sa.c[3];
    *(u32x4*)(bufp + T_V + off_b(tid >> 4, tid & 15)) = p.vv;
}
template <bool FULL> __device__ __forceinline__ void stageB(unsigned char* bufp, int tid, const StA& sa, f32x2& dsum) {
    const int lane = tid & 63, w = __builtin_amdgcn_readfirstlane(tid >> 6);
    f32x2 pre = {0.f, 0.f}, bl = {0.f, 0.f};
#pragma unroll
    for (int ww = 0; ww < 8; ++ww) { const f32x2 t = *(const f32x2*)(bufp + T_TOT + (ww * 128 + 2 * lane) * 4); if (ww < w) pre += t; bl += t; }
#pragma unroll
    for (int i = 0; i < 4; ++i) {
        const f32x2 b = pre + sa.c[i];
        const float k0 = 1.0f - __builtin_amdgcn_exp2f(sa.l[i].x), k1 = 1.0f - __builtin_amdgcn_exp2f(sa.l[i].y);
        const unsigned addr = off_b(4 * w + i, lane >> 2) + (lane & 3) * 4;
        *(unsigned*)(bufp + T_KT + addr) = cvtpk(k0 * __builtin_amdgcn_exp2f(bl.x - b.x), k1 * __builtin_amdgcn_exp2f(bl.y - b.y));
        if (FULL) {
            *(unsigned*)(bufp + T_QH + addr) = cvtpk(bflo(sa.qv[i]) * __builtin_amdgcn_exp2f(b.x), bfhi(sa.qv[i]) * __builtin_amdgcn_exp2f(b.y));
            *(unsigned*)(bufp + T_KD + addr) = cvtpk(k0 * __builtin_amdgcn_exp2f(fminf(-b.x, 115.f)), k1 * __builtin_amdgcn_exp2f(fminf(-b.y, 115.f)));
        }
    }
    if (w == 0) { f32x2 e; e.x = __builtin_amdgcn_exp2f(bl.x); e.y = __builtin_amdgcn_exp2f(bl.y); *(f32x2*)(bufp + T_DEC + 2 * lane * 4) = e; }
    dsum += bl;
}
__device__ __forceinline__ bf16x8 load_vfrag(unsigned char* bufp, int tid) {
    const int lane = tid & 63, w = __builtin_amdgcn_readfirstlane(tid >> 6); const unsigned lds0 = (unsigned)(uintptr_t)bufp;
    const s16x4 vlo = tr_ld(lds0 + T_V + tr_read_addr_16(lane, w, 0)), vhi = tr_ld(lds0 + T_V + tr_read_addr_16(lane, w, 1));
    HG_LGKM0();
    return HG_CAT(vlo, vhi);
}
__device__ __forceinline__ void stageC(unsigned char* shm, unsigned char* bufp, int tid, const f32x4 (&S)[8], f32x4 (&o)[2]) {
    const int lane = tid & 63, w = __builtin_amdgcn_readfirstlane(tid >> 6), g = lane >> 4, l15 = lane & 15;
    o[0] = (f32x4){0.f, 0.f, 0.f, 0.f}; o[1] = (f32x4){0.f, 0.f, 0.f, 0.f};
    if (w < 3) {
        const int rb = w > 0 ? 1 : 0, cb = w == 2 ? 1 : 0; f32x4 sc = {0.f, 0.f, 0.f, 0.f};
#pragma unroll
        for (int ks = 0; ks < 4; ++ks) { const bf16x8 A = *(const bf16x8*)(bufp + T_QH + row_read_addr_16(lane, rb, ks)), B = *(const bf16x8*)(bufp + T_KD + row_read_addr_16(lane, cb, ks)); sc = mfma16(A, B, sc); }
#pragma unroll
        for (int i = 0; i < 4; ++i) { const int tl = 4 * g + i; const float v = (rb != cb || l15 <= tl) ? sc[i] : 0.f;
            *(unsigned short*)(shm + T_P + (16 * rb + tl) * PST + (16 * cb + l15) * 2) = (unsigned short)f2bf(v); }
    }
#pragma unroll
    for (int ks = 0; ks < 4; ++ks) {
        u32x4 bw = {cvtpk(S[2 * ks][0], S[2 * ks][1]), cvtpk(S[2 * ks][2], S[2 * ks][3]), cvtpk(S[2 * ks + 1][0], S[2 * ks + 1][1]), cvtpk(S[2 * ks + 1][2], S[2 * ks + 1][3])};
        const bf16x8 Bf = *reinterpret_cast<bf16x8*>(&bw);
#pragma unroll
        for (int rb = 0; rb < 2; ++rb) { const unsigned t = l15 + 16 * rb;
            const u32x2 alo = *(const u32x2*)(bufp + T_QH + off_b(t, 4 * ks + (g >> 1)) + 8 * (g & 1)), ahi = *(const u32x2*)(bufp + T_QH + off_b(t, 4 * ks + 2 + (g >> 1)) + 8 * (g & 1));
            u32x4 aw = {alo.x, alo.y, ahi.x, ahi.y}; o[rb] = mfma16(*reinterpret_cast<bf16x8*>(&aw), Bf, o[rb]); }
    }
}
template <bool FULL> __device__ __forceinline__ void stageD(unsigned char* shm, unsigned char* bufp, int tid, f32x4 (&S)[8], f32x4 (&o)[2]) {
    const int lane = tid & 63, w = __builtin_amdgcn_readfirstlane(tid >> 6), g = lane >> 4, l15 = lane & 15; const unsigned lds0 = (unsigned)(uintptr_t)bufp;
    const bf16x8 vf = load_vfrag(bufp, tid);
    if (FULL) {
#pragma unroll
        for (int rb = 0; rb < 2; ++rb) { const bf16x8 A = *(const bf16x8*)(shm + T_P + (l15 + 16 * rb) * PST + 16 * g); o[rb] = mfma16(A, vf, o[rb]); }
#pragma unroll
        for (int rb = 0; rb < 2; ++rb)
#pragma unroll
            for (int i = 0; i < 4; ++i) *(float*)(shm + T_O + ((16 * rb + 4 * g + i) * OST + 16 * w + l15) * 4) = o[rb][i];
    }
#pragma unroll
    for (int kt = 0; kt < 8; kt += 2) {
        const s16x4 k0l = tr_ld(lds0 + T_KT + tr_read_addr_16(lane, kt, 0)), k0h = tr_ld(lds0 + T_KT + tr_read_addr_16(lane, kt, 1));
        const s16x4 k1l = tr_ld(lds0 + T_KT + tr_read_addr_16(lane, kt + 1, 0)), k1h = tr_ld(lds0 + T_KT + tr_read_addr_16(lane, kt + 1, 1));
        const f32x4 d0 = *(const f32x4*)(bufp + T_DEC + (16 * kt + 4 * g) * 4), d1 = *(const f32x4*)(bufp + T_DEC + (16 * (kt + 1) + 4 * g) * 4);
        HG_LGKM0();
        S[kt] = mfma16(HG_CAT(k0l, k0h), vf, S[kt] * d0); S[kt + 1] = mfma16(HG_CAT(k1l, k1h), vf, S[kt + 1] * d1);
    }
}
__device__ __forceinline__ void stageE(const Args& a, unsigned char* shm, int tid, int r0, int h, int jl, const u32x4 gv) {
    const int vrow = tid >> 4, vch = tid & 15, c0 = 8 * vch; const float* hw = a.in[10] + jl * HD + c0; bf16* OG = (bf16*)(a.ws + WS_OG);
    const f32x4 x0 = *(const f32x4*)(shm + T_O + (vrow * OST + c0) * 4), x1 = *(const f32x4*)(shm + T_O + (vrow * OST + c0 + 4) * 4);
    float ss = (x0.x * x0.x + x0.y * x0.y) + (x0.z * x0.z + x0.w * x0.w) + (x1.x * x1.x + x1.y * x1.y) + (x1.z * x1.z + x1.w * x1.w);
    ss += __shfl_xor(ss, 1); ss += __shfl_xor(ss, 2); ss += __shfl_xor(ss, 4); ss += __shfl_xor(ss, 8);
    const float rn = rsqrtf(ss * (1.0f / HD) + EPS); const f32x4 h0 = *(const f32x4*)hw, h1 = *(const f32x4*)(hw + 4);
    u32x4 wv;
    wv.x = cvtpk(x0.x * rn * h0.x * bflo(gv.x), x0.y * rn * h0.y * bfhi(gv.x)); wv.y = cvtpk(x0.z * rn * h0.z * bflo(gv.y), x0.w * rn * h0.w * bfhi(gv.y));
    wv.z = cvtpk(x1.x * rn * h1.x * bflo(gv.z), x1.y * rn * h1.y * bfhi(gv.z)); wv.w = cvtpk(x1.z * rn * h1.z * bflo(gv.w), x1.w * rn * h1.w * bfhi(gv.w));
    *(u32x4*)(OG + (size_t)(r0 + vrow) * D + h * HD + c0) = wv;
}
template <bool FULL> __device__ __forceinline__ void run_chunks(const Args& a, unsigned char* shm, int r0, int nst, int h, int jl, f32x4 (&S)[8], f32x2& dsum, int tid) {
    Pre pA, pB; StA sa; u32x4 gvA = {0u, 0u, 0u, 0u}, gvB = {0u, 0u, 0u, 0u}; f32x4 o[2];
    load_chunk<FULL>(a, r0, h, tid, pA); if (nst > 1) load_chunk<FULL>(a, r0 + 32, h, tid, pB);
    stageA<FULL>(shm, tid, pA, sa, gvA); if (nst > 2) load_chunk<FULL>(a, r0 + 64, h, tid, pA);
    WG_BAR();
    stageB<FULL>(shm, tid, sa, dsum);
    WG_BAR();
#define HG_TURN(M, BC, BN, PN, GN, GE) do { const int m_ = (M); \
        if (FULL) { if (m_ > 0) stageE(a, shm, tid, r0 + 32 * (m_ - 1), h, jl, GE); stageC(shm, shm + (BC) * BUFSZ, tid, S, o); } \
        else stageD<false>(shm, shm + (BC) * BUFSZ, tid, S, o); \
        if (m_ + 1 < nst) { stageA<FULL>(shm + (BN) * BUFSZ, tid, PN, sa, GN); if (m_ + 3 < nst) load_chunk<FULL>(a, r0 + 32 * (m_ + 3), h, tid, PN); } \
        WG_BAR(); \
        if (FULL) stageD<true>(shm, shm + (BC) * BUFSZ, tid, S, o); \
        if (m_ + 1 < nst) stageB<FULL>(shm + (BN) * BUFSZ, tid, sa, dsum); \
        WG_BAR(); } while (0)
    for (int m = 0; m < nst; m += 2) {
        HG_TURN(m, 0, 1, pB, gvB, gvB);
        if (m + 1 < nst) HG_TURN(m + 1, 1, 0, pA, gvA, gvA);
    }
#undef HG_TURN
    if (FULL) stageE(a, shm, tid, r0 + 32 * (nst - 1), h, jl, ((nst - 1) & 1) ? gvB : gvA);
}
__device__ __forceinline__ size_t st_off(int kt, int i, int g, int w, int l15) { return (size_t)(16 * kt + 4 * g + i) * HD + 16 * w + l15; }

__device__ __forceinline__ void unit_pass1(const Args& a, unsigned char* shm, int jl, int b, int h, int seg) {
    const int tid = fresh_tid(), lane = tid & 63, w = __builtin_amdgcn_readfirstlane(tid >> 6), g = lane >> 4, l15 = lane & 15;
    f32x4 S[8];
#pragma unroll
    for (int kt = 0; kt < 8; ++kt) S[kt] = (f32x4){0.f, 0.f, 0.f, 0.f};
    f32x2 dsum = {0.f, 0.f};
    run_chunks<false>(a, shm, b * TP + seg * SEG, SEG / 32, h, jl, S, dsum, tid);
    float* L = (float*)(a.ws + WS_HL) + (size_t)((b * NH + h) * (NSEG - 1) + seg) * HD * HD;
#pragma unroll
    for (int kt = 0; kt < 8; ++kt)
#pragma unroll
        for (int i = 0; i < 4; ++i) L[st_off(kt, i, g, w, l15)] = S[kt][i];
    if (w == 0) *(f32x2*)((float*)(a.ws + WS_HL + HL_DG) + (size_t)((b * NH + h) * (NSEG - 1) + seg) * HD + 2 * lane) = dsum;
}
__device__ __forceinline__ void unit_pass2(const Args& a, unsigned char* shm, int jl, bool prompt, int b, int h, int seg) {
    const int tid = fresh_tid(), lane = tid & 63, w = __builtin_amdgcn_readfirstlane(tid >> 6), g = lane >> 4, l15 = lane & 15;
    f32x4 S[8];
#pragma unroll
    for (int kt = 0; kt < 8; ++kt) S[kt] = (f32x4){0.f, 0.f, 0.f, 0.f};
    if (prompt) {
        for (int sp = 0; sp < seg; ++sp) {
            const float* L = (const float*)(a.ws + WS_HL) + (size_t)((b * NH + h) * (NSEG - 1) + sp) * HD * HD;
            const float* Dg = (const float*)(a.ws + WS_HL + HL_DG) + (size_t)((b * NH + h) * (NSEG - 1) + sp) * HD;
#pragma unroll
            for (int kt = 0; kt < 8; ++kt) { const f32x4 dg = *(const f32x4*)(Dg + 16 * kt + 4 * g);
#pragma unroll
                for (int i = 0; i < 4; ++i) S[kt][i] = S[kt][i] * __builtin_amdgcn_exp2f(dg[i]) + L[st_off(kt, i, g, w, l15)]; }
        }
    } else {
        const float* S0 = a.in[4] + ((size_t)(jl * BS + b) * NH + h) * HD * HD;
#pragma unroll
        for (int kt = 0; kt < 8; ++kt)
#pragma unroll
            for (int i = 0; i < 4; ++i) S[kt][i] = S0[st_off(kt, i, g, w, l15)];
    }
    for (int u = tid; u < 32 * PST / 4; u += 512) ((unsigned*)(shm + T_P))[u] = 0u;
    f32x2 dsum = {0.f, 0.f};
    const int nst = prompt ? SEG / 32 : TS / 32, r0 = prompt ? b * TP + seg * SEG : MP + b * TS;
    run_chunks<true>(a, shm, r0, nst, h, jl, S, dsum, tid);
    if (!prompt || seg == NSEG - 1) {
        float* So = prompt ? a.out + O_SP + ((size_t)(jl * BP + b) * NH + h) * HD * HD : a.out + O_SS + ((size_t)(jl * BS + b) * NH + h) * HD * HD;
#pragma unroll
        for (int kt = 0; kt < 8; ++kt)
#pragma unroll
            for (int i = 0; i < 4; ++i) So[st_off(kt, i, g, w, l15)] = S[kt][i];
    }
    __syncthreads();
}
}
__device__ __forceinline__ void ph_hgrn1(const Args& a, unsigned char* shm, int bid, int nblk, int layer) {
    for (int it = bid; it < BP * NH * (hg::NSEG - 1); it += nblk) { const int seg = it % (hg::NSEG - 1), bh = it / (hg::NSEG - 1); hg::unit_pass1(a, shm, layer >> 1, bh / NH, bh % NH, seg); }
}
__device__ __forceinline__ void ph_hgrn2(const Args& a, unsigned char* shm, int bid, int nblk, int layer) {
    for (int it = bid; it < BP * NH * hg::NSEG + BS * NH; it += nblk) {
        if (it < BP * NH * hg::NSEG) { const int seg = it % hg::NSEG, bh = it / hg::NSEG; hg::unit_pass2(a, shm, layer >> 1, true, bh / NH, bh % NH, seg); }
        else { const int u = it - BP * NH * hg::NSEG; hg::unit_pass2(a, shm, layer >> 1, false, u / NH, u % NH, 0); }
    }
}


constexpr int WGM_G1 = 4, WGM_G2 = 4;
#define EPI_BAR() do { asm volatile("s_waitcnt lgkmcnt(0)" ::: "memory"); __builtin_amdgcn_s_barrier(); asm volatile("" ::: "memory"); } while (0)
__device__ __forceinline__ u32x4 pack8(const f32x4 a, const f32x4 b) { u32x4 w; w.x = pg8::cvt_pk_bf16(a.x, a.y); w.y = pg8::cvt_pk_bf16(a.z, a.w); w.z = pg8::cvt_pk_bf16(b.x, b.y); w.w = pg8::cvt_pk_bf16(b.z, b.w); return w; }
__device__ __forceinline__ f32x4 silu4(const f32x4 x) { f32x4 r; r.x = silu_f(x.x); r.y = silu_f(x.y); r.z = silu_f(x.z); r.w = silu_f(x.w); return r; }
__device__ __forceinline__ float sq4(const f32x4 x) { return (x.x * x.x + x.y * x.y) + (x.z * x.z + x.w * x.w); }

constexpr int RS_OFF = EPI_OFF + 8192, RS_TAG_OFF = RS_OFF + 1024;
static_assert(RS_TAG_OFF + 16 <= LDS_BYTES, "LDS map");
__device__ __forceinline__ const float* rstd_table(const float* ssq, float* scr, int row0, int nrows, int wr, int wc, int fr, int fq) {
    float* rs = scr + (RS_OFF - EPI_OFF) / 4; volatile int* tag = (volatile int*)(scr + (RS_TAG_OFF - EPI_OFF) / 4);
    if (__builtin_amdgcn_readfirstlane(*tag) != row0) {
        const int t = (wr * 4 + wc) * 64 + fq * 16 + fr;
        if (t < nrows) rs[t] = row_rstd(ssq, row0 + t);
        EPI_BAR();
        if (t == 0) *tag = row0;
        EPI_BAR();
    }
    return rs;
}
struct EpiG1Attn {
    static constexpr bool PERM = true, AFTER_DRAIN = false;
    const float* ssq; bf16* QB; bf16* KB; bf16* VB; bf16* GB; float* out; const float* qw; const float* kw; float* scr; int j;
    __device__ __forceinline__ void operator()(const pg8::f32x4 (&acc)[2][2][4][2], const pg8::Unit& u, int wr, int wc, int fr, int fq) const { run<2>(acc, u.pm * 256, u.pn, wr, wc, fr, fq, true); }
    template <int NAI> __device__ __forceinline__ void run(const pg8::f32x4 (&acc)[2][2][4][2], int row0, int pn, int wr, int wc, int fr, int fq, bool active) const {
        const int grp = pn >> 3, cD = 256 * (pn & 7) + 32 * wc + 8 * fq, rl0 = 64 * wr + fr; const bool prompt = row0 < MP;
        const float* rst = rstd_table(ssq, scr, row0, 128 * NAI, wr, wc, fr, fq);
        if (grp < 2) {
            if (active) {
#pragma unroll
                for (int ai = 0; ai < NAI; ++ai)
#pragma unroll
                    for (int m = 0; m < 4; ++m)
#pragma unroll
                        for (int bj = 0; bj < 2; ++bj) { float s = sq4(acc[ai][bj][m][0]) + sq4(acc[ai][bj][m][1]); s += __shfl_xor(s, 16); s += __shfl_xor(s, 32);
                            if (fq == 0) scr[((128 * ai + rl0 + 16 * m) * 2 + bj) * 4 + wc] = s; }
            }
            EPI_BAR();
            if (!active) return;
            const float* wp = (grp == 0 ? qw : kw) + 32 * wc + 8 * fq; const float gsc = grp == 0 ? QSCALE : 1.0f;
            const f32x4 w0 = *(const f32x4*)wp * gsc, w1 = *(const f32x4*)(wp + 4) * gsc;
            bf16* dst = grp == 0 ? QB : KB;
#pragma unroll
            for (int ai = 0; ai < NAI; ++ai)
#pragma unroll
                for (int m = 0; m < 4; ++m) { const int rl = 128 * ai + rl0 + 16 * m; const size_t ro = (size_t)(row0 + rl) * D + cD; const float r1 = rst[rl];
#pragma unroll
                    for (int bj = 0; bj < 2; ++bj) { const f32x4 t4 = *(const f32x4*)(scr + (rl * 2 + bj) * 4); const float tot = (t4.x + t4.y) + (t4.z + t4.w);
                        const float rn = r1 * rsqrtf(r1 * r1 * tot * (1.0f / HD) + EPS);
                        const f32x4 v0 = acc[ai][bj][m][0] * rn * w0, v1 = acc[ai][bj][m][1] * rn * w1;
                        *(u32x4*)(dst + ro + 128 * bj) = pack8(v0, v1);
                        if (grp == 1) { float* ko = (prompt ? out + O_KP + (size_t)j * MP * D + ro : out + O_KS + (size_t)j * MS * D + (ro - (size_t)MP * D)) + 128 * bj; *(f32x4*)ko = v0; *(f32x4*)(ko + 4) = v1; } }
                    asm volatile("" ::: "memory"); }
        } else if (grp == 2) {
            if (!active) return;
#pragma unroll
            for (int ai = 0; ai < NAI; ++ai)
#pragma unroll
                for (int m = 0; m < 4; ++m) { const int rl = 128 * ai + rl0 + 16 * m; const size_t ro = (size_t)(row0 + rl) * D + cD; const float r1 = rst[rl];
#pragma unroll
                    for (int bj = 0; bj < 2; ++bj) { const f32x4 v0 = acc[ai][bj][m][0] * r1, v1 = acc[ai][bj][m][1] * r1;
                        *(u32x4*)(VB + ro + 128 * bj) = pack8(v0, v1);
                        float* vo = (prompt ? out + O_VP + (size_t)j * MP * D + ro : out + O_VS + (size_t)j * MS * D + (ro - (size_t)MP * D)) + 128 * bj; *(f32x4*)vo = v0; *(f32x4*)(vo + 4) = v1; }
                    asm volatile("" ::: "memory"); }
        } else {
            if (!active) return;
#pragma unroll
            for (int ai = 0; ai < NAI; ++ai)
#pragma unroll
                for (int m = 0; m < 4; ++m) { const int rl = 128 * ai + rl0 + 16 * m; const size_t ro = (size_t)(row0 + rl) * D + cD; const float r1 = rst[rl];
#pragma unroll
                    for (int bj = 0; bj < 2; ++bj) *(u32x4*)(GB + ro + 128 * bj) = pack8(silu4(acc[ai][bj][m][0] * r1), silu4(acc[ai][bj][m][1] * r1));
                    asm volatile("" ::: "memory"); }
        }
    }
};
struct EpiG1Hgrn {
    static constexpr bool PERM = true, AFTER_DRAIN = false;
    const float* ssq; bf16* QB; float* LF; bf16* VB; bf16* GB; const float* oml; float* scr;
    __device__ __forceinline__ void operator()(const pg8::f32x4 (&acc)[2][2][4][2], const pg8::Unit& u, int wr, int wc, int fr, int fq) const { run<2>(acc, u.pm * 256, u.pn, wr, wc, fr, fq, true); }
    template <int NAI> __device__ __forceinline__ void run(const pg8::f32x4 (&acc)[2][2][4][2], int row0, int pn, int wr, int wc, int fr, int fq, bool active) const {
        const int grp = pn >> 3, cD = 256 * (pn & 7) + 32 * wc + 8 * fq, rl0 = 64 * wr + fr;
        const float* rst = rstd_table(ssq, scr, row0, 128 * NAI, wr, wc, fr, fq);
        if (!active) return;
        f32x4 om[2][2];
        if (grp == 1) {
#pragma unroll
            for (int bj = 0; bj < 2; ++bj) { om[bj][0] = *(const f32x4*)(oml + cD + 128 * bj); om[bj][1] = *(const f32x4*)(oml + cD + 128 * bj + 4); } }
#pragma unroll
        for (int ai = 0; ai < NAI; ++ai)
#pragma unroll
            for (int m = 0; m < 4; ++m) { const int rl = 128 * ai + rl0 + 16 * m; const size_t ro = (size_t)(row0 + rl) * D + cD; const float r1 = rst[rl];
#pragma unroll
                for (int bj = 0; bj < 2; ++bj) { const f32x4 v0 = acc[ai][bj][m][0] * r1, v1 = acc[ai][bj][m][1] * r1;
                    if (grp == 0) *(u32x4*)(QB + ro + 128 * bj) = pack8(silu4(v0), silu4(v1));
                    else if (grp == 2) *(u32x4*)(VB + ro + 128 * bj) = pack8(v0, v1);
                    else if (grp == 3) *(u32x4*)(GB + ro + 128 * bj) = pack8(silu4(v0), silu4(v1));
                    else { f32x4 l0, l1;
#pragma unroll
                        for (int e = 0; e < 4; ++e) { const float m0 = om[bj][0][e], m1 = om[bj][1][e];
                            l0[e] = fminf(__logf(fmaxf(1.0f - m0, 1e-30f) + m0 / (1.0f + __expf(-v0[e]))), 0.f); l1[e] = fminf(__logf(fmaxf(1.0f - m1, 1e-30f) + m1 / (1.0f + __expf(-v1[e]))), 0.f); }
                        *(f32x4*)(LF + ro + 128 * bj) = l0; *(f32x4*)(LF + ro + 128 * bj + 4) = l1; } }
                asm volatile("" ::: "memory"); }
    }
};
struct EpiG2 {
    static constexpr bool PERM = true, AFTER_DRAIN = false;
    const float* base_p; const float* base_s; float* out; bf16* XB; float* ssq; float* scr;
    __device__ __forceinline__ void operator()(const pg8::f32x4 (&acc)[2][2][4][2], const pg8::Unit& u, int wr, int wc, int fr, int fq) const { run<2>(acc, u.pm * 256, u.pn, wr, wc, fr, fq, true); }
    template <int NAI> __device__ __forceinline__ void run(const pg8::f32x4 (&acc)[2][2][4][2], int row0, int pn, int wr, int wc, int fr, int fq, bool active) const {
        const int c0 = 256 * pn + 32 * wc + 8 * fq, rl0 = 64 * wr + fr; const bool prompt = row0 < MP;
        if (active) {
            const size_t ro0 = (size_t)((prompt ? row0 : row0 - MP) + rl0) * D + c0;
            const float* bp = (prompt ? base_p : base_s) + ro0; float* op = (prompt ? out + O_YP : out + O_YS) + ro0;
            f32x4 pre[4][4];
#define G2_LOAD(slot, q) do { const float* p_ = bp + (size_t)(128 * ((q) >> 2) + 16 * ((q) & 3)) * D; pre[slot][0] = *(const f32x4*)p_; pre[slot][1] = *(const f32x4*)(p_ + 4); pre[slot][2] = *(const f32x4*)(p_ + 128); pre[slot][3] = *(const f32x4*)(p_ + 132); } while (0)
            G2_LOAD(0, 0); G2_LOAD(1, 1); if (NAI * 4 > 2) G2_LOAD(2, 2);
            asm volatile("" ::: "memory");
#pragma unroll
            for (int q = 0; q < 4 * NAI; ++q) { const int ai = q >> 2, m = q & 3, rl = 128 * ai + rl0 + 16 * m;
                if (q + 3 < 4 * NAI) G2_LOAD((q + 3) % 4, q + 3);
                asm volatile("" ::: "memory");
                float* o_ = op + (size_t)(128 * ai + 16 * m) * D; bf16* xb = XB + (size_t)(row0 + rl) * D + c0;
                const f32x4 x0 = pre[q % 4][0] + acc[ai][0][m][0], x1 = pre[q % 4][1] + acc[ai][0][m][1], x2 = pre[q % 4][2] + acc[ai][1][m][0], x3 = pre[q % 4][3] + acc[ai][1][m][1];
                *(f32x4*)o_ = x0; *(f32x4*)(o_ + 4) = x1; *(f32x4*)(o_ + 128) = x2; *(f32x4*)(o_ + 132) = x3;
                *(u32x4*)xb = pack8(x0, x1); *(u32x4*)(xb + 128) = pack8(x2, x3);
                float s = (sq4(x0) + sq4(x1)) + (sq4(x2) + sq4(x3));
                s += __shfl_xor(s, 16); s += __shfl_xor(s, 32);
                if (fq == 0) scr[rl * 4 + wc] = s;
                asm volatile("" ::: "memory"); }
#undef G2_LOAD
        }
        EPI_BAR();
        if (active && wc == 0 && fq == 0) {
#pragma unroll
            for (int ai = 0; ai < NAI; ++ai)
#pragma unroll
                for (int m = 0; m < 4; ++m) { const int rl = 128 * ai + rl0 + 16 * m; const f32x4 t4 = *(const f32x4*)(scr + rl * 4); ssq[(size_t)(row0 + rl) * 8 + pn] = (t4.x + t4.y) + (t4.z + t4.w); }
        }
    }
};

template <class Epi> __device__ __forceinline__ void skinny_unit(PG8_LAS unsigned char* lds, const bf16* A, const bf16* Bt, int K, const Epi& E, int row0, int pn) {
    using pg8::bf16x8; using pg8::f32x4;
    const int tid = fresh_tid(), wid = __builtin_amdgcn_readfirstlane(tid >> 6), lane = tid & 63, wr = wid >> 2, wc = wid & 3, fr = lane & 15, fq = lane >> 4;
    const int nt = K / 64;
    unsigned voffA, voffB[2];
    { int R, C; pg8::stage_rc(tid * 16, R, C); voffA = (unsigned)(R * K + C) * 2u; }
#pragma unroll
    for (int i = 0; i < 2; ++i) { int R, C; pg8::stage_rc(tid * 16 + i * 8192, R, C); const int Rb = (R & ~31) + pg8::perm32(R & 31); voffB[i] = (unsigned)(Rb * K + C) * 2u; }
    const char* gA = (const char*)(A + (size_t)row0 * K); const char* gB = (const char*)(Bt + (size_t)pn * 256 * K);
    const size_t hstep = (size_t)128 * K * 2; const unsigned ldsw = (unsigned)wid * 1024u;
    const int aoff = pg8::lds_byte(fr, fq * 8), boff = pg8::lds_byte(wc * 32 + fr, fq * 8);
    constexpr int STG = 40960;
#define SK_STAGE(s, kt) do { const size_t ko_ = (size_t)(kt) * 128; \
        __builtin_amdgcn_global_load_lds((const unsigned*)(gA + voffA + ko_), (PG8_LAS unsigned*)(lds + (s) * STG + ldsw), 16, 0, 0); \
        _Pragma("unroll") for (int h_ = 0; h_ < 2; ++h_) _Pragma("unroll") for (int i_ = 0; i_ < 2; ++i_) \
            __builtin_amdgcn_global_load_lds((const unsigned*)(gB + h_ * hstep + voffB[i_] + ko_), (PG8_LAS unsigned*)(lds + (s) * STG + 8192 + h_ * 16384 + ldsw + i_ * 8192), 16, 0, 0); } while (0)
    f32x4 acc[2][2][4][2];
#pragma unroll
    for (int a = 0; a < 2; ++a)
#pragma unroll
        for (int b = 0; b < 2; ++b)
#pragma unroll
            for (int m = 0; m < 4; ++m)
#pragma unroll
                for (int n = 0; n < 2; ++n) acc[a][b][m][n] = (f32x4){0.f, 0.f, 0.f, 0.f};
    SK_STAGE(0, 0); SK_STAGE(1, 1);
    int s = 0;
    for (int kt = 0; kt < nt; ++kt) {
        if (kt + 1 < nt) asm volatile("s_waitcnt vmcnt(5)" ::: "memory"); else asm volatile("s_waitcnt vmcnt(0)" ::: "memory");
        __builtin_amdgcn_s_barrier(); asm volatile("" ::: "memory");
        if (kt + 2 < nt) { const int s2 = s >= 1 ? s - 1 : 2; SK_STAGE(s2, kt + 2); }
        if (wr == 0) {
            bf16x8 At[4][2], B0[2][2], B1[2][2];
#pragma unroll
            for (int m = 0; m < 4; ++m)
#pragma unroll
                for (int k = 0; k < 2; ++k) At[m][k] = *(const PG8_LAS bf16x8*)(lds + s * STG + aoff + m * 2048 + k * 1024);
#pragma unroll
            for (int n = 0; n < 2; ++n)
#pragma unroll
                for (int k = 0; k < 2; ++k) { B0[n][k] = *(const PG8_LAS bf16x8*)(lds + s * STG + 8192 + boff + n * 2048 + k * 1024); B1[n][k] = *(const PG8_LAS bf16x8*)(lds + s * STG + 8192 + 16384 + boff + n * 2048 + k * 1024); }
#pragma unroll
            for (int m = 0; m < 4; ++m)
#pragma unroll
                for (int n = 0; n < 2; ++n)
#pragma unroll
                    for (int k = 0; k < 2; ++k) { acc[0][0][m][n] = __builtin_amdgcn_mfma_f32_16x16x32_bf16(B0[n][k], At[m][k], acc[0][0][m][n], 0, 0, 0);
                                                  acc[0][1][m][n] = __builtin_amdgcn_mfma_f32_16x16x32_bf16(B1[n][k], At[m][k], acc[0][1][m][n], 0, 0, 0); }
        }
        s = s == 2 ? 0 : s + 1;
    }
#undef SK_STAGE
    asm volatile("s_waitcnt lgkmcnt(0)" ::: "memory"); __builtin_amdgcn_s_barrier(); asm volatile("" ::: "memory");
    E.template run<1>(acc, row0, pn, wr, wc, fr, fq, wr == 0);
}
__device__ __forceinline__ void skinny_map(int unit, int ncol, int& ps, int& pn) {
    const int x = unit & 7, r = unit >> 3, per = ncol / 8;
    ps = r & 7; pn = x * per + (r >> 3);
}

__device__ __forceinline__ void ph_gemm1_attn(const Args& a, unsigned char* shm, int bid, int nblk, int layer) {
    const int j = layer >> 1;
    pg8::Gemm g{(const bf16*)(a.ws + WS_XB), (const bf16*)(a.ws + WS_WIN) + (size_t)layer * NP * D, MP, NP, D};
    pg8::StaticOrder S; S.init(MP, NP, nblk, bid, WGM_G1);
    EpiG1Attn E{(const float*)(a.ws + WS_SSQ), (bf16*)(a.ws + WS_QB), (bf16*)(a.ws + WS_KB), (bf16*)(a.ws + WS_VB), (bf16*)(a.ws + WS_GB), a.out, a.in[8] + j * HD, a.in[9] + j * HD, (float*)(shm + EPI_OFF), j};
    if (threadIdx.x == 0) *(volatile int*)(shm + RS_TAG_OFF) = -1;
    __syncthreads();
    pg8::gemm_phase<EpiG1Attn, pg8::StaticOrder, true, true>((LAS unsigned char*)shm, g, S, E);
    for (int unit = bid; unit < (MS / 64) * (NP / 256); unit += nblk) { int ps, pn; skinny_map(unit, NP / 256, ps, pn); skinny_unit((LAS unsigned char*)shm, g.A, g.Bt, D, E, MP + 64 * ps, pn); }
}
__device__ __forceinline__ void ph_gemm1_hgrn(const Args& a, unsigned char* shm, int bid, int nblk, int layer) {
    const int j = layer >> 1;
    pg8::Gemm g{(const bf16*)(a.ws + WS_XB), (const bf16*)(a.ws + WS_WIN) + (size_t)layer * NP * D, MP, NP, D};
    pg8::StaticOrder S; S.init(MP, NP, nblk, bid, WGM_G1);
    EpiG1Hgrn E{(const float*)(a.ws + WS_SSQ), (bf16*)(a.ws + WS_QB), (float*)(a.ws + WS_LF), (bf16*)(a.ws + WS_VB), (bf16*)(a.ws + WS_GB), (const float*)(a.ws + WS_OML) + j * D, (float*)(shm + EPI_OFF)};
    if (threadIdx.x == 0) *(volatile int*)(shm + RS_TAG_OFF) = -1;
    __syncthreads();
    pg8::gemm_phase<EpiG1Hgrn, pg8::StaticOrder, true, true>((LAS unsigned char*)shm, g, S, E);
    for (int unit = bid; unit < (MS / 64) * (NP / 256); unit += nblk) { int ps, pn; skinny_map(unit, NP / 256, ps, pn); skinny_unit((LAS unsigned char*)shm, g.A, g.Bt, D, E, MP + 64 * ps, pn); }
}
__device__ __forceinline__ void ph_gemm2(const Args& a, unsigned char* shm, int bid, int nblk, int layer) {
    pg8::Gemm g{(const bf16*)(a.ws + WS_OG), (const bf16*)(a.ws + WS_WOUT) + (size_t)layer * D * D, MP, D, D};
    pg8::StaticOrder S; S.init(MP, D, nblk, bid, WGM_G2);
    EpiG2 E{layer == 0 ? a.in[0] : a.out + O_YP, layer == 0 ? a.in[1] : a.out + O_YS, a.out, (bf16*)(a.ws + WS_XB), (float*)(a.ws + WS_SSQ), (float*)(shm + EPI_OFF)};
    pg8::gemm_phase<EpiG2, pg8::StaticOrder, true, true>((LAS unsigned char*)shm, g, S, E);
    constexpr int NSK = (MS / 64) * (D / 256);
    for (int unit = bid; unit < NSK; unit += nblk) { int ps, pn; skinny_map(unit, D / 256, ps, pn); skinny_unit((LAS unsigned char*)shm, g.A, g.Bt, D, E, MP + 64 * ps, pn); }
    if (layer + 1 < DEPTH) {
        const int tid = fresh_tid(), lane = tid & 63, wave = tid >> 6; unsigned char* scr = shm + wave * (64 * 132);
        if (nblk > NSK) { if (bid >= NSK) convert_layer_weights(a, scr, layer + 1, (bid - NSK) * 8 + wave, (nblk - NSK) * 8, lane); }
        else convert_layer_weights(a, scr, layer + 1, bid * 8 + wave, nblk * 8, lane);
    }
}


constexpr int CW_BAR = 4096;
static_assert((CW_BAR + XCD_BAR_WORDS) * 4 <= (int)CTL_BYTES, "CTL region");

__global__ void __launch_bounds__(512, 2) mega_fwd(Args a) {
    extern __shared__ __attribute__((aligned(16))) unsigned char shm[];
    const int tid = threadIdx.x, bid = blockIdx.x, nblk = gridDim.x;
    for (int u = tid; u < 256; u += 512) ((LAS unsigned*)((LAS unsigned char*)shm + LDSCTL_OFF))[u] = 0u;
    __syncthreads();
    XcdBarrier bar = xcd_barrier_post((unsigned*)(a.ws + WS_CTL) + CW_BAR, (volatile LAS unsigned*)((LAS unsigned char*)shm + LDSCTL_OFF + 32));
    prologue_phase(a, shm, bid, nblk);
    xcd_barrier(bar);
#define LAYER_ATTN(L) do { ph_gemm1_attn(a, shm, bid, nblk, (L)); xcd_barrier(bar); ph_attn(a, shm, bid, nblk, (L)); xcd_barrier(bar); ph_gemm2(a, shm, bid, nblk, (L)); xcd_barrier(bar); } while (0)
#define LAYER_HGRN(L) do { ph_gemm1_hgrn(a, shm, bid, nblk, (L)); xcd_barrier(bar); ph_hgrn1(a, shm, bid, nblk, (L)); xcd_barrier(bar); ph_hgrn2(a, shm, bid, nblk, (L)); xcd_barrier(bar); ph_gemm2(a, shm, bid, nblk, (L)); xcd_barrier(bar); } while (0)
    LAYER_ATTN(0); LAYER_HGRN(1); LAYER_ATTN(2); LAYER_HGRN(3);
#undef LAYER_ATTN
#undef LAYER_HGRN
}

extern "C" void kernel_launch(void* const* d_in, const int* in_sizes, int n_in, void* d_out, int out_size, void* d_ws, size_t ws_size, hipStream_t stream) {
    static int grid = 0;
    if (grid == 0) {
        if (n_in != 12 || (size_t)out_size != O_END || ws_size < WS_END) { fprintf(stderr, "kernel_launch: unexpected shapes n_in %d out %d ws %zu\n", n_in, out_size, ws_size); grid = -1; return; }
        int dev = 0, cus = 0, per_cu = 0;
        if (hipGetDevice(&dev) != hipSuccess || hipDeviceGetAttribute(&cus, hipDeviceAttributeMultiprocessorCount, dev) != hipSuccess) { fprintf(stderr, "kernel_launch: device query failed\n"); grid = -1; return; }
        if (hipFuncSetAttribute((const void*)mega_fwd, hipFuncAttributeMaxDynamicSharedMemorySize, LDS_BYTES) != hipSuccess) { fprintf(stderr, "kernel_launch: hipFuncSetAttribute failed\n"); grid = -1; return; }
        if (hipOccupancyMaxActiveBlocksPerMultiprocessor(&per_cu, (const void*)mega_fwd, 512, LDS_BYTES) != hipSuccess || per_cu < 1) { fprintf(stderr, "kernel_launch: occupancy query says %d blocks per CU\n", per_cu); (void)hipGetLastError(); grid = -1; return; }
        grid = cus;
    }
    if (grid < 0) return;
    if (hipMemsetAsync((char*)d_ws + WS_CTL, 0, CTL_BYTES, stream) != hipSuccess) { fprintf(stderr, "kernel_launch: memset failed\n"); return; }
    Args a; memset(&a, 0, sizeof(a));
    for (int i = 0; i < 12; ++i) a.in[i] = (const float*)d_in[i];
    a.out = (float*)d_out; a.ws = (unsigned char*)d_ws;
    hipLaunchKernelGGL(mega_fwd, dim3(grid), dim3(512), LDS_BYTES, stream, a);
    const hipError_t le = hipPeekAtLastError();
    if (le != hipSuccess) fprintf(stderr, "kernel_launch: launch failed: %s\n", hipGetErrorName(le));
}
```

```cpp
#include <hip/hip_runtime.h>
#include <cstdio>
#include <cstdint>
#include <cstring>
__device__ __forceinline__ int fresh_tid() { int t = threadIdx.x; asm volatile("" : "+v"(t)); return t; }
namespace pg8 {
#define PG8_LAS __attribute__((address_space(3)))
typedef unsigned short bf16_t;
typedef short bf16x8 __attribute__((ext_vector_type(8)));
typedef float f32x4 __attribute__((ext_vector_type(4)));
typedef unsigned u32x4 __attribute__((ext_vector_type(4)));
constexpr int BM = 256, BK = 64, HALF = 128, HTB = HALF * BK * 2  , STAGE_BYTES = 8 * HTB, NXCD = 8, WGM = 4;

__host__ __device__ __forceinline__ int lds_byte(int r, int c) { const int st = (r >> 4) * 2 + (c >> 5), rr = r & 15, cc = c & 31, ob = rr * 64 + cc * 2; return st * 1024 + (ob ^ (((ob >> 9) & 1) << 5)); }
__host__ __device__ __forceinline__ void stage_rc(int b, int& R, int& C) { const int st = b / 1024, sb = b % 1024, swz = sb ^ (((sb >> 9) & 1) << 5); R = (st >> 1) * 16 + swz / 64; C = (st & 1) * 32 + (swz % 64) / 2; }
__host__ __device__ __forceinline__ int perm32(int rho) { const int n = rho >> 4, i = rho & 15; return 8 * (i >> 2) + 4 * n + (i & 3); }

struct Unit { int pm, pn; };
struct Gemm { const bf16_t* A; const bf16_t* Bt; int M, N, K; };

struct StaticOrder {
    int nM, nN, nwg, G, c;
    __host__ __device__ void init(int M, int N, int G_, int c_) { nM = M / BM; nN = N / BM; nwg = nM * nN; G = G_; c = c_; }
    __host__ __device__ bool next(int i, Unit& u) const {
        const long L = (long)i * G + c; if (L >= nwg) return false;
        int wgid = (int)L; { const int q = nwg / NXCD, r = nwg % NXCD, xcd = wgid % NXCD, off = wgid / NXCD; wgid = (xcd < r ? xcd * (q + 1) : r * (q + 1) + (xcd - r) * q) + off; }
        const int nig = WGM * nN, gid = wgid / nig, fm = gid * WGM, gsz = (nM - fm) < WGM ? (nM - fm) : WGM;
        u.pm = fm + ((wgid % nig) % gsz); u.pn = (wgid % nig) / gsz; return true;
    }
    __device__ __forceinline__ void a_ready(const Unit&) const {}
    __device__ __forceinline__ void done(const Unit&) const {}
};

__device__ __forceinline__ unsigned cvt_pk_bf16(float lo, float hi) { unsigned r; asm volatile("v_cvt_pk_bf16_f32 %0, %1, %2" : "=v"(r) : "v"(lo), "v"(hi)); return r; }
typedef float f32x2 __attribute__((ext_vector_type(2)));
template <class Epi, class Sched, bool ALIGN_EPI = false, bool SP2 = false>
__device__ __forceinline__ void gemm_phase(PG8_LAS unsigned char* lds, const Gemm g, const Sched& S, const Epi& E) {
    const int tid = fresh_tid(), wid = __builtin_amdgcn_readfirstlane(tid >> 6), lane = tid & 63, wr = wid >> 2, wc = wid & 3, fr = lane & 15, fq = lane >> 4;
    const int K = g.K, nt = K / BK;
    unsigned voffA[2], voffB[2];
#pragma unroll
    for (int i = 0; i < 2; ++i) { int R, C; stage_rc(tid * 16 + i * 8192, R, C); const int Rb = Epi::PERM ? ((R & ~31) + perm32(R & 31)) : R;
        voffA[i] = (unsigned)(R * K + C) * 2u; voffB[i] = (unsigned)(Rb * K + C) * 2u; }
    const size_t kstep = (size_t)(BK * 2);
    const size_t hstep = (size_t)HALF * K * 2;
    const size_t tstep = 2 * hstep;
    const unsigned ldsw = (unsigned)wid * 1024u;
    const int aoff = lds_byte(wr * 64 + fr, fq * 8), boff = lds_byte(wc * 32 + fr, fq * 8);
#define PG8_SA(b, h) (((b) * 2 + (h)) * HTB)
#define PG8_SB(b, h) ((4 + (b) * 2 + (h)) * HTB)
#define PG8_STAGE(bufoff, gbase, voff) do { _Pragma("unroll") for (int _i = 0; _i < 2; ++_i) \
        __builtin_amdgcn_global_load_lds((const unsigned*)((const char*)(gbase) + (voff)[_i]), (PG8_LAS unsigned*)(lds + (bufoff) + ldsw + _i * 8192), 16, 0, 0); } while (0)
#define PG8_LDA(dst, b, h) do { _Pragma("unroll") for (int m = 0; m < 4; ++m) _Pragma("unroll") for (int k = 0; k < 2; ++k) dst[m][k] = *(const PG8_LAS bf16x8*)(lds + PG8_SA(b, h) + aoff + m * 2048 + k * 1024); } while (0)
#define PG8_LDB(dst, b, h) do { _Pragma("unroll") for (int n = 0; n < 2; ++n) _Pragma("unroll") for (int k = 0; k < 2; ++k) dst[n][k] = *(const PG8_LAS bf16x8*)(lds + PG8_SB(b, h) + boff + n * 2048 + k * 1024); } while (0)
#define PG8_MMA(ai, bj, At, Bt) do { __builtin_amdgcn_s_setprio(1); _Pragma("unroll") for (int m = 0; m < 4; ++m) _Pragma("unroll") for (int n = 0; n < 2; ++n) _Pragma("unroll") for (int k = 0; k < 2; ++k) \
        acc[ai][bj][m][n] = __builtin_amdgcn_mfma_f32_16x16x32_bf16(Bt[n][k], At[m][k], acc[ai][bj][m][n], 0, 0, 0); __builtin_amdgcn_s_setprio(0); } while (0)
#define PG8_WAIT_V(n) asm volatile("s_waitcnt vmcnt(" #n ")" ::: "memory")
#define PG8_WAIT_L(n) asm volatile("s_waitcnt lgkmcnt(" #n ")" ::: "memory")
#define PG8_BAR __builtin_amdgcn_s_barrier()
#define PG8_SCHED __builtin_amdgcn_sched_barrier(0)
    Unit cur, nxt; int ui = 0;
    if (!S.next(0, cur)) return;
    f32x4 acc[2][2][4][2];
#pragma unroll
    for (int a = 0; a < 2; ++a)
#pragma unroll
        for (int b = 0; b < 2; ++b)
#pragma unroll
            for (int m = 0; m < 4; ++m)
#pragma unroll
                for (int n = 0; n < 2; ++n) acc[a][b][m][n] = (f32x4){0.f, 0.f, 0.f, 0.f};
    bf16x8 At[4][2], B0[2][2], B1[2][2];
    const char* cA = (const char*)g.A + (size_t)cur.pm * tstep; const char* cB = (const char*)g.Bt + (size_t)cur.pn * tstep;
    S.a_ready(cur);
    if constexpr (SP2) {
        PG8_STAGE(PG8_SB(0, 0), cB, voffB); PG8_STAGE(PG8_SB(0, 1), cB + hstep, voffB); PG8_STAGE(PG8_SA(0, 0), cA, voffA); PG8_STAGE(PG8_SA(0, 1), cA + hstep, voffA);
        if (wr == 1) PG8_BAR;
        PG8_WAIT_V(2); PG8_BAR;
        PG8_STAGE(PG8_SB(1, 0), cB + kstep, voffB); PG8_STAGE(PG8_SA(1, 0), cA + kstep, voffA); PG8_STAGE(PG8_SB(1, 1), cB + hstep + kstep, voffB);
        PG8_WAIT_V(6); PG8_BAR;
    } else {
        PG8_STAGE(PG8_SB(0, 0), cB, voffB); PG8_STAGE(PG8_SA(0, 0), cA, voffA); PG8_STAGE(PG8_SB(0, 1), cB + hstep, voffB); PG8_STAGE(PG8_SA(0, 1), cA + hstep, voffA);
        if (wr == 1) PG8_BAR;
        PG8_WAIT_V(4); PG8_BAR;
        PG8_STAGE(PG8_SB(1, 0), cB + kstep, voffB); PG8_STAGE(PG8_SA(1, 0), cA + kstep, voffA); PG8_STAGE(PG8_SB(1, 1), cB + hstep + kstep, voffB);
        PG8_WAIT_V(6); PG8_BAR;
    }
    for (;;) {
        const bool has_next = S.next(ui + 1, nxt);
        const char* nA = has_next ? (const char*)g.A + (size_t)nxt.pm * tstep : cA; const char* nB = has_next ? (const char*)g.Bt + (size_t)nxt.pn * tstep : cB;
        asm volatile(".p2align 8" ::: "memory");
        for (int t = 0; t < nt; t += 2) {
            const bool last = (t == nt - 2);
            const char* a1 = cA + (size_t)(t + 1) * kstep;
            const char* a2 = last ? nA : cA + (size_t)(t + 2) * kstep; const char* b2 = last ? nB : cB + (size_t)(t + 2) * kstep;
            const char* a3 = a2 + kstep; const char* b3 = b2 + kstep;
            if (last && has_next) S.a_ready(nxt);
            if constexpr (SP2) {
            PG8_LDB(B0, 0, 0); PG8_LDB(B1, 0, 1); PG8_SCHED; PG8_LDA(At, 0, 0); PG8_STAGE(PG8_SA(1, 1), a1 + hstep, voffA);
            PG8_WAIT_V(8); PG8_WAIT_L(0); PG8_BAR; PG8_MMA(0, 0, At, B0); PG8_MMA(0, 1, At, B1); PG8_BAR; PG8_SCHED;
            PG8_LDA(At, 0, 1); PG8_STAGE(PG8_SB(0, 0), b2, voffB); PG8_STAGE(PG8_SB(0, 1), b2 + hstep, voffB); PG8_STAGE(PG8_SA(0, 0), a2, voffA);
            PG8_WAIT_V(8); PG8_WAIT_L(0); PG8_BAR; PG8_MMA(1, 0, At, B0); PG8_MMA(1, 1, At, B1); PG8_BAR; PG8_SCHED;
            PG8_LDB(B0, 1, 0); PG8_LDB(B1, 1, 1); PG8_SCHED; PG8_LDA(At, 1, 0); PG8_STAGE(PG8_SA(0, 1), a2 + hstep, voffA);
            PG8_WAIT_V(8); PG8_WAIT_L(0); PG8_BAR; PG8_MMA(0, 0, At, B0); PG8_MMA(0, 1, At, B1); PG8_BAR; PG8_SCHED;
            PG8_LDA(At, 1, 1); PG8_STAGE(PG8_SB(1, 0), b3, voffB); PG8_STAGE(PG8_SB(1, 1), b3 + hstep, voffB); PG8_STAGE(PG8_SA(1, 0), a3, voffA);
            PG8_WAIT_V(8); PG8_WAIT_L(0); PG8_BAR; PG8_MMA(1, 0, At, B0); PG8_MMA(1, 1, At, B1); PG8_BAR; PG8_SCHED;
            } else {
            PG8_LDB(B0, 0, 0); PG8_SCHED; PG8_LDA(At, 0, 0); PG8_STAGE(PG8_SA(1, 1), a1 + hstep, voffA);
            PG8_WAIT_L(8); PG8_BAR; PG8_WAIT_L(0); PG8_MMA(0, 0, At, B0); PG8_BAR; PG8_SCHED;
            PG8_LDB(B1, 0, 1); PG8_STAGE(PG8_SB(0, 0), b2, voffB);
            PG8_BAR; PG8_WAIT_L(0); PG8_MMA(0, 1, At, B1); PG8_BAR;
            PG8_LDA(At, 0, 1); PG8_STAGE(PG8_SA(0, 0), a2, voffA);
            PG8_BAR; PG8_WAIT_L(0); PG8_MMA(1, 0, At, B0); PG8_BAR; PG8_SCHED;
            PG8_STAGE(PG8_SB(0, 1), b2 + hstep, voffB);
            PG8_WAIT_V(6); PG8_BAR; PG8_MMA(1, 1, At, B1); PG8_BAR;
            PG8_LDB(B0, 1, 0); PG8_SCHED; PG8_LDA(At, 1, 0); PG8_STAGE(PG8_SA(0, 1), a2 + hstep, voffA);
            PG8_WAIT_L(8); PG8_BAR; PG8_WAIT_L(0); PG8_MMA(0, 0, At, B0); PG8_BAR; PG8_SCHED;
            PG8_LDB(B1, 1, 1); PG8_STAGE(PG8_SB(1, 0), b3, voffB);
            PG8_BAR; PG8_WAIT_L(0); PG8_MMA(0, 1, At, B1); PG8_BAR;
            PG8_LDA(At, 1, 1); PG8_STAGE(PG8_SA(1, 0), a3, voffA);
            PG8_BAR; PG8_WAIT_L(0); PG8_MMA(1, 0, At, B0); PG8_BAR; PG8_SCHED;
            PG8_STAGE(PG8_SB(1, 1), b3 + hstep, voffB);
            PG8_WAIT_V(6); PG8_BAR; PG8_MMA(1, 1, At, B1); PG8_BAR;
            }
        }
        if constexpr (ALIGN_EPI) { if (wr == 0) PG8_BAR; }
        if constexpr (!Epi::AFTER_DRAIN) { E(acc, cur, wr, wc, fr, fq); S.done(cur); }
        if (!has_next) break;
#pragma unroll
        for (int a = 0; a < 2; ++a)
#pragma unroll
            for (int b = 0; b < 2; ++b)
#pragma unroll
                for (int m = 0; m < 4; ++m)
#pragma unroll
                    for (int n = 0; n < 2; ++n) acc[a][b][m][n] = (f32x4){0.f, 0.f, 0.f, 0.f};
        cur = nxt; cA = nA; cB = nB; ++ui;
        if constexpr (ALIGN_EPI) { if (wr == 1) PG8_BAR; }
    }
    PG8_WAIT_V(0);
    if constexpr (!ALIGN_EPI) { if (wr == 0) PG8_BAR; }
    PG8_BAR;
    if constexpr (Epi::AFTER_DRAIN) { E.fused(acc, cur, wr, wc, fr, fq, lds, wid, lane); S.done(cur); }
#undef PG8_SA
#undef PG8_SB
#undef PG8_STAGE
#undef PG8_LDA
#undef PG8_LDB
#undef PG8_MMA
#undef PG8_WAIT_V
#undef PG8_WAIT_L
#undef PG8_BAR
#undef PG8_SCHED
}
}

constexpr int D = 2048, NH = 16, HD = 128, NP = 8192, DEPTH = 4;
constexpr int BP = 4, TP = 4096, MP = BP * TP;
constexpr int BS = 16, TS = 32, MS = BS * TS, PAST = 2048;
constexpr int M = MP + MS;
constexpr float EPS = 1e-6f;
constexpr float LOG2E = 1.4426950408889634f;
constexpr float QSCALE = 0.08838834764831845f * LOG2E;
constexpr float SB_EXIT_LIN = 1e-24f;
constexpr size_t O_YP = 0, O_YS = O_YP + (size_t)MP * D, O_KP = O_YS + (size_t)MS * D, O_VP = O_KP + 2 * (size_t)MP * D, O_SP = O_VP + 2 * (size_t)MP * D,
                 O_KS = O_SP + 2 * (size_t)BP * NH * HD * HD, O_VS = O_KS + 2 * (size_t)MS * D, O_SS = O_VS + 2 * (size_t)MS * D, O_END = O_SS + 2 * (size_t)BS * NH * HD * HD;
static_assert(O_END == 183500800ull, "output size");
constexpr size_t MiB = 1u << 20;
constexpr size_t WS_CTL = 0, CTL_BYTES = 1 * MiB;
constexpr size_t WS_WIN = 1 * MiB;
constexpr size_t WS_WOUT = 129 * MiB;
constexpr size_t WS_XB = 161 * MiB;
constexpr size_t WS_SSQ = 227 * MiB;
constexpr size_t WS_OML = WS_SSQ + 768 * 1024;
constexpr size_t WS_QB = 228 * MiB, WS_KB = 294 * MiB, WS_VB = 360 * MiB, WS_GB = 426 * MiB;
constexpr size_t WS_LF = 492 * MiB;
constexpr size_t WS_OG = 624 * MiB;
constexpr size_t WS_HL = 690 * MiB;
constexpr size_t WS_END = 706 * MiB;

#define LAS __attribute__((address_space(3)))
typedef unsigned short bf16;
typedef float f32x4 __attribute__((ext_vector_type(4)));
typedef float f32x2 __attribute__((ext_vector_type(2)));
typedef unsigned u32x4 __attribute__((ext_vector_type(4)));
typedef unsigned u32x2 __attribute__((ext_vector_type(2)));
__device__ __forceinline__ float bf2f(unsigned short b) { return __uint_as_float(((unsigned)b) << 16); }
__device__ __forceinline__ float bflo(unsigned w) { return __uint_as_float(w << 16); }
__device__ __forceinline__ float bfhi(unsigned w) { return __uint_as_float(w & 0xffff0000u); }
__device__ __forceinline__ unsigned f2bf(float f) { unsigned u = __float_as_uint(f); return (u + 0x7fffu + ((u >> 16) & 1u)) >> 16; }
__device__ __forceinline__ unsigned pk2(float lo, float hi) { return f2bf(lo) | (f2bf(hi) << 16); }
__device__ __forceinline__ float wave_sum(float v) {
#pragma unroll
    for (int o = 1; o < 64; o <<= 1) v += __shfl_xor(v, o);
    return v;
}
__device__ __forceinline__ float silu_f(float x) { return x * __builtin_amdgcn_rcpf(1.0f + __expf(-x)); }

#define WG_BAR() do { asm volatile("s_waitcnt lgkmcnt(0)" ::: "memory"); __builtin_amdgcn_s_barrier(); asm volatile("" ::: "memory"); } while (0)
__device__ __forceinline__ size_t hm(int row, int h) { return ((size_t)h * M + row) * HD; }
struct Args { const float* in[12]; float* out; unsigned char* ws; };

__device__ __forceinline__ float row_rstd(const float* ssq, int row) {
    const f32x4 a = *(const f32x4*)(ssq + (size_t)row * 8), b = *(const f32x4*)(ssq + (size_t)row * 8 + 4);
    const float s = ((a.x + a.y) + (a.z + a.w)) + ((b.x + b.y) + (b.z + b.w));
    return rsqrtf(s * (1.0f / D) + EPS);
}
__device__ __forceinline__ float hgrn_lower_bound(const float* hgrn_lb, int j, int c) {
    if (j == 0) return 0.0f;
    const float l0 = hgrn_lb[c], l1 = hgrn_lb[D + c], mx = fmaxf(l0, l1), e0 = __expf(l0 - mx), e1 = __expf(l1 - mx);
    return fminf(fmaxf(e1 / (e0 + e1), 0.0f), 1.0f - 1e-6f);
}

constexpr int RING_BYTES = 131072;
constexpr int LDSCTL_OFF = RING_BYTES;
constexpr int EPI_OFF = LDSCTL_OFF + 1024;
constexpr int LDS_BYTES = 147456;
static_assert(EPI_OFF + 8192 <= LDS_BYTES, "LDS map");
#define XB_TMO      128
#define XB_XCNT(j)  (256  + 64 * (j))
#define XB_XSUB(j)  (1280 + 64 * (j))
#define XB_XGEN(j)  (2304 + 64 * (j))
#define XB_TOP      3328
#define XB_TOPGEN   3392
#define XCD_BAR_WORDS 3456
#define XB_SPIN_CAP (1u << 18)

__device__ __forceinline__ unsigned xb_ld(unsigned* p)              { return __hip_atomic_load(p, __ATOMIC_RELAXED, __HIP_MEMORY_SCOPE_AGENT); }
__device__ __forceinline__ unsigned xb_add(unsigned* p, unsigned v) { return __hip_atomic_fetch_add(p, v, __ATOMIC_RELAXED, __HIP_MEMORY_SCOPE_AGENT); }
__device__ __forceinline__ unsigned xb_xcc_id() { return (unsigned)__builtin_amdgcn_s_getreg((3 << 11) | 20) & 0xFu; }
#define XB_SPIN(cond, bar) do { unsigned _sp = 0; while (cond) { __builtin_amdgcn_s_sleep(1); \
    if ((++_sp & 255u) == 0u) { if (xb_ld(&(bar)[XB_TMO])) break; if (_sp > XB_SPIN_CAP) { atomicAdd(&(bar)[XB_TMO], 1u); break; } } } } while (0)

struct XcdBarrier {
    unsigned* bar; unsigned x;
    volatile LAS unsigned* st;
};

__device__ __forceinline__ XcdBarrier xcd_barrier_post(unsigned* bar, volatile LAS unsigned* st) {
    XcdBarrier b; b.bar = bar; b.x = xb_xcc_id(); b.st = st;
    if (threadIdx.x == 0) (void)xb_add(&bar[XB_XCNT(b.x)], 1u);
    return b;
}
__device__ __forceinline__ void xcd_barrier_complete(unsigned* bar, unsigned x, unsigned& nloc, unsigned& nx) {
    const unsigned G = gridDim.x * gridDim.y * gridDim.z;
    unsigned sum, cnt, mine, sp = 0u;
    for (;;) {
        sum = 0u; cnt = 0u; mine = 0u;
#pragma unroll
        for (unsigned j = 0; j < 16; ++j) { const unsigned c = xb_ld(&bar[XB_XCNT(j)]); sum += c; cnt += (c > 0u) ? 1u : 0u; mine = (j == x) ? c : mine; }
        if (sum == G) break;
        __builtin_amdgcn_s_sleep(1);
        if ((++sp & 255u) == 0u) { if (xb_ld(&bar[XB_TMO])) break; if (sp > XB_SPIN_CAP) { atomicAdd(&bar[XB_TMO], 1u); break; } }
    }
    nloc = mine > 0u ? mine : 1u; nx = cnt > 0u ? cnt : 1u;
}

__device__ __forceinline__ void xcd_barrier(const XcdBarrier& b) {
    asm volatile("s_waitcnt vmcnt(0)" ::: "memory");
    __syncthreads();
    if (threadIdx.x == 0) {
        unsigned* bar = b.bar;
        __builtin_amdgcn_s_waitcnt(0);
        unsigned nloc = b.st[0], nx = b.st[1];
        if (nloc == 0u) { xcd_barrier_complete(bar, b.x, nloc, nx); b.st[0] = nloc; b.st[1] = nx; }
        const unsigned old = xb_add(&bar[XB_XSUB(b.x)], 1u);
        const unsigned gen = old / nloc;
        if (old + 1u == (gen + 1u) * nloc) {
            __builtin_amdgcn_fence(__ATOMIC_RELEASE, "agent");
            asm volatile("s_waitcnt vmcnt(0)" ::: "memory");
            const unsigned og = xb_add(&bar[XB_TOP], 1u);
            const unsigned tg = og / nx;
            if (og + 1u == (tg + 1u) * nx) xb_add(&bar[XB_TOPGEN], 1u);
            else XB_SPIN(xb_ld(&bar[XB_TOPGEN]) == tg, bar);
            __builtin_amdgcn_fence(__ATOMIC_ACQUIRE, "agent");
            xb_add(&bar[XB_XGEN(b.x)], 1u);
            asm volatile("s_waitcnt vmcnt(0)" ::: "memory");
        } else {
            XB_SPIN(xb_ld(&bar[XB_XGEN(b.x)]) == gen, bar);
            __builtin_amdgcn_fence(__ATOMIC_ACQUIRE, "agent");
            asm volatile("s_waitcnt vmcnt(0)" ::: "memory");
        }
    }
    __syncthreads();
}
__device__ __forceinline__ void transpose_item(const float* W, const float* kscale, int K, int N, bf16* WT, unsigned char* scr, int item, int lane) {
    const int nblk = N / 64, kb = item / nblk, nb = item % nblk, k0 = 64 * kb, n0 = 64 * nb, ks = lane >> 4, n4 = (lane & 15) * 4;
    f32x4 v[16];
#pragma unroll
    for (int i = 0; i < 8; ++i) { const float* src = W + (size_t)(k0 + 8 * i + 2 * ks) * N + n0 + n4; v[2 * i] = *(const f32x4*)src; v[2 * i + 1] = *(const f32x4*)(src + N); }
    f32x2 sc[8];
#pragma unroll
    for (int i = 0; i < 8; ++i) { if (kscale) sc[i] = *(const f32x2*)(kscale + k0 + 8 * i + 2 * ks); else sc[i] = (f32x2){1.f, 1.f}; }
#pragma unroll
    for (int i = 0; i < 8; ++i)
#pragma unroll
        for (int e = 0; e < 4; ++e) *(unsigned*)(scr + (n4 + e) * 132 + 16 * i + 4 * ks) = pg8::cvt_pk_bf16(v[2 * i][e] * sc[i].x, v[2 * i + 1][e] * sc[i].y);
    __builtin_amdgcn_s_waitcnt(0xc07f); asm volatile("" ::: "memory");
    const int c = lane & 7;
#pragma unroll
    for (int ps = 0; ps < 8; ++ps) { const int n = (lane >> 3) + 8 * ps; const unsigned char* s = scr + n * 132 + 16 * c;
        u32x4 o; o.x = *(const unsigned*)s; o.y = *(const unsigned*)(s + 4); o.z = *(const unsigned*)(s + 8); o.w = *(const unsigned*)(s + 12);
        *(u32x4*)(WT + (size_t)(n0 + n) * K + k0 + 8 * c) = o; }
    __builtin_amdgcn_s_waitcnt(0xc07f); asm volatile("" ::: "memory");
}
__device__ __forceinline__ void convert_layer_weights(const Args& a, unsigned char* scr, int l, int gw, int ngw, int lane) {
    const float* norm_w = a.in[5]; const float* w_in = a.in[6]; const float* w_out = a.in[7];
    bf16* WinT = (bf16*)(a.ws + WS_WIN); bf16* WoutT = (bf16*)(a.ws + WS_WOUT);
    constexpr int I_IN = (D / 64) * (NP / 64), I_OUT = (D / 64) * (D / 64);
    for (int r = gw; r < I_IN + I_OUT; r += ngw) {
        if (r < I_IN) transpose_item(w_in + (size_t)l * D * NP, norm_w + l * D, D, NP, WinT + (size_t)l * NP * D, scr, r, lane);
        else transpose_item(w_out + (size_t)l * D * D, nullptr, D, D, WoutT + (size_t)l * D * D, scr, r - I_IN, lane);
    }
}
__device__ __forceinline__ void prologue_phase(const Args& a, unsigned char* shm, int bid, int nblk) {
    const int tid = fresh_tid(), lane = tid & 63, wave = tid >> 6;
    unsigned char* scr = shm + wave * (64 * 132);
    const int gw = bid * 8 + wave, NGW = nblk * 8;
    convert_layer_weights(a, scr, 0, gw, NGW, lane);
    if (bid == 0) { float* oml = (float*)(a.ws + WS_OML); for (int c = tid; c < 2 * D; c += 512) oml[c] = 1.0f - hgrn_lower_bound(a.in[11], c / D, c % D); }
    bf16* XB = (bf16*)(a.ws + WS_XB); float* ssq = (float*)(a.ws + WS_SSQ);
    for (int row = gw; row < M; row += NGW) {
        const float* src = row < MP ? a.in[0] + (size_t)row * D : a.in[1] + (size_t)(row - MP) * D;
        float s = 0.f;
#pragma unroll
        for (int j = 0; j < 8; ++j) { const f32x4 v = *(const f32x4*)(src + 4 * (lane + 64 * j)); s += (v.x * v.x + v.y * v.y) + (v.z * v.z + v.w * v.w);
            u32x2 o; o.x = pg8::cvt_pk_bf16(v.x, v.y); o.y = pg8::cvt_pk_bf16(v.z, v.w); *(u32x2*)(XB + (size_t)row * D + 4 * (lane + 64 * j)) = o; }
        s = wave_sum(s);
        if (lane < 8) ssq[(size_t)row * 8 + lane] = lane == 0 ? s : 0.f;
    }
}


namespace att {
using bf16x8 = __attribute__((ext_vector_type(8))) short;
using s16x4  = __attribute__((ext_vector_type(4))) short;
using f32x16 = __attribute__((ext_vector_type(16))) float;
constexpr int SHM_T = 64 * 128 * 2;
#define ATT_KSWZ(row, colB) ((row) * 256 + ((colB) ^ (((row) & 7) << 4)))
__device__ __forceinline__ int crow(int r, int hi) { return (r & 3) + 8 * (r >> 2) + 4 * hi; }
__device__ __forceinline__ unsigned cvtpk(float lo, float hi) { unsigned r; asm volatile("v_cvt_pk_bf16_f32 %0, %1, %2" : "=v"(r) : "v"(lo), "v"(hi)); return r; }
__device__ __forceinline__ int v_st(int k, int c) { const int kk = (k & ~0xC) | ((k & 4) << 1) | ((k & 8) >> 1); return ((kk >> 3) * 4 + (c >> 5)) * 512 + ((kk & 7) * 32 + (c & 31)) * 2; }
__device__ __forceinline__ int v_rd_base(int lane) { return ((lane & 3) << 3) | (((lane >> 2) & 3) << 6) | (((lane >> 4) & 1) << 5) | (((lane >> 5) & 1) << 8); }
constexpr int v_rd_off(int d0, int ks, int half) { return d0 * 512 + ks * 4096 + half * 2048; }
template <int OFF> __device__ __forceinline__ s16x4 tr_read(int vb) { s16x4 r; asm volatile("ds_read_b64_tr_b16 %0, %1 offset:%2" : "=&v"(r) : "v"(vb), "i"(OFF) : "memory"); return r; }
__device__ __forceinline__ void qkt(f32x16& p0, f32x16& p1, const char* Ks, const bf16x8* qr, int r32, int hi) {
    p0 = f32x16{}; p1 = f32x16{};
#pragma unroll
    for (int d0 = 0; d0 < 8; ++d0) { const int cb = (d0 * 16 + hi * 8) * 2;
        const bf16x8 b0 = *reinterpret_cast<const bf16x8*>(Ks + ATT_KSWZ(r32, cb));
        const bf16x8 b1 = *reinterpret_cast<const bf16x8*>(Ks + ATT_KSWZ(32 + r32, cb));
        p0 = __builtin_amdgcn_mfma_f32_32x32x16_bf16(b0, qr[d0], p0, 0, 0, 0);
        p1 = __builtin_amdgcn_mfma_f32_32x32x16_bf16(b1, qr[d0], p1, 0, 0, 0); }
}
template <int D0> __device__ __forceinline__ void pv_one(f32x16& od, int vb, bf16x8 pa0, bf16x8 pa1, bf16x8 pa2, bf16x8 pa3) {
    const s16x4 l0 = tr_read<v_rd_off(D0, 0, 0)>(vb), h0 = tr_read<v_rd_off(D0, 0, 1)>(vb), l1 = tr_read<v_rd_off(D0, 1, 0)>(vb), h1 = tr_read<v_rd_off(D0, 1, 1)>(vb);
    const s16x4 l2 = tr_read<v_rd_off(D0, 2, 0)>(vb), h2 = tr_read<v_rd_off(D0, 2, 1)>(vb), l3 = tr_read<v_rd_off(D0, 3, 0)>(vb), h3 = tr_read<v_rd_off(D0, 3, 1)>(vb);
    asm volatile("s_waitcnt lgkmcnt(0)" ::: "memory"); __builtin_amdgcn_sched_barrier(0);
#define ATT_PK(L, H) (bf16x8){L[0], L[1], L[2], L[3], H[0], H[1], H[2], H[3]}
    od = __builtin_amdgcn_mfma_f32_32x32x16_bf16(ATT_PK(l0, h0), pa0, od, 0, 0, 0);
    od = __builtin_amdgcn_mfma_f32_32x32x16_bf16(ATT_PK(l1, h1), pa1, od, 0, 0, 0);
    od = __builtin_amdgcn_mfma_f32_32x32x16_bf16(ATT_PK(l2, h2), pa2, od, 0, 0, 0);
    od = __builtin_amdgcn_mfma_f32_32x32x16_bf16(ATT_PK(l3, h3), pa3, od, 0, 0, 0);
#undef ATT_PK
}
template <bool CHECK_NEG, bool MASK> __device__ __forceinline__ float sb_half(f32x16& p, float C, int kpos0, int qpos, int hi) {
    float om[16];
#pragma unroll
    for (int r = 0; r < 16; ++r) { const float e = __builtin_amdgcn_exp2f(fminf(p[r], 80.f)), q = __builtin_amdgcn_rcpf(1.0f + e); float be = e * q, o1 = q;
        if (MASK) { const int pos = kpos0 + crow(r, hi); const bool valid = (pos < qpos) && (!CHECK_NEG || pos >= 0); be = valid ? be : 0.f; o1 = valid ? o1 : 1.f; }
        p[r] = be; om[r] = o1; }
    float s[4], ex[4];
#pragma unroll
    for (int g = 0; g < 4; ++g) {
        const float o0 = om[4 * g], o1 = om[4 * g + 1], o2 = om[4 * g + 2], o3 = om[4 * g + 3];
        const float e2 = o3, e1 = e2 * o2, e0 = e1 * o1, tt = e0 * o0;
        om[4 * g + 3] = 1.f; om[4 * g + 2] = e2; om[4 * g + 1] = e1; om[4 * g] = e0;
        const auto rr = __builtin_amdgcn_permlane32_swap(__float_as_uint(tt), __float_as_uint(tt), false, false);
        s[g] = __uint_as_float(rr[0]) * __uint_as_float(rr[1]); ex[g] = hi ? 1.f : __uint_as_float(rr[1]); }
    float base[4];
    base[3] = C; base[2] = base[3] * s[3]; base[1] = base[2] * s[2]; base[0] = base[1] * s[1];
    const float Cn = base[0] * s[0];
#pragma unroll
    for (int g = 0; g < 4; ++g) { const float bg = base[g] * ex[g];
        p[4 * g + 3] *= bg; p[4 * g + 2] *= om[4 * g + 2] * bg; p[4 * g + 1] *= om[4 * g + 1] * bg; p[4 * g] *= om[4 * g] * bg; }
    return Cn;
}
#define ATT_PK4(P, BASE, OUT) do { const unsigned a0_ = cvtpk(P[BASE + 0], P[BASE + 1]), a1_ = cvtpk(P[BASE + 2], P[BASE + 3]); \
    const unsigned b0_ = cvtpk(P[BASE + 4], P[BASE + 5]), b1_ = cvtpk(P[BASE + 6], P[BASE + 7]); \
    const auto r0_ = __builtin_amdgcn_permlane32_swap(a0_, b0_, false, false); const auto r1_ = __builtin_amdgcn_permlane32_swap(a1_, b1_, false, false); \
    u32x4 w_ = {r0_[0], r1_[0], r0_[1], r1_[1]}; OUT = *reinterpret_cast<bf16x8*>(&w_); } while (0)

struct Stg { bf16x8 k0, k1, v0, v1; };
__device__ __forceinline__ bf16x8 cvt8(const float* p) { const f32x4 x = *(const f32x4*)p, y = *(const f32x4*)(p + 4); u32x4 w = {cvtpk(x.x, x.y), cvtpk(x.z, x.w), cvtpk(y.x, y.y), cvtpk(y.z, y.w)}; return *reinterpret_cast<bf16x8*>(&w); }
template <bool SAMPLE> __device__ __forceinline__ void load_kv(const Args& a, int j, int b, int h, int pb, int sr, int sc, Stg& st) {
    const bf16* KB = (const bf16*)(a.ws + WS_KB); const bf16* VB = (const bf16*)(a.ws + WS_VB);
    if constexpr (!SAMPLE) {
        const size_t o0 = hm(b * TP + pb + sr, h) + sc, o1 = o0 + (size_t)32 * HD;
        st.k0 = *(const bf16x8*)(KB + o0); st.k1 = *(const bf16x8*)(KB + o1); st.v0 = *(const bf16x8*)(VB + o0); st.v1 = *(const bf16x8*)(VB + o1);
    } else {
        const float* ck = a.in[2] + ((size_t)(j * BS + b) * PAST) * D + h * HD + sc; const float* cv = a.in[3] + ((size_t)(j * BS + b) * PAST) * D + h * HD + sc;
        const bf16x8 zero = {0, 0, 0, 0, 0, 0, 0, 0};
        const int p0 = pb + sr, p1 = pb + 32 + sr;
        if (p0 >= PAST) { const size_t o = hm(MP + b * TS + (p0 - PAST), h) + sc; st.k0 = *(const bf16x8*)(KB + o); st.v0 = *(const bf16x8*)(VB + o); }
        else if (p0 >= 0) { st.k0 = cvt8(ck + (size_t)p0 * D); st.v0 = cvt8(cv + (size_t)p0 * D); }
        else { st.k0 = zero; st.v0 = zero; }
        if (p1 >= PAST) { const size_t o = hm(MP + b * TS + (p1 - PAST), h) + sc; st.k1 = *(const bf16x8*)(KB + o); st.v1 = *(const bf16x8*)(VB + o); }
        else if (p1 >= 0) { st.k1 = cvt8(ck + (size_t)p1 * D); st.v1 = cvt8(cv + (size_t)p1 * D); }
        else { st.k1 = zero; st.v1 = zero; }
    }
}
__device__ __forceinline__ void write_kv(char* V_lds, char* K_lds, int buf, int sr, int sc, const Stg& st) {
    *(bf16x8*)(V_lds + buf * SHM_T + v_st(sr, sc)) = st.v0; *(bf16x8*)(V_lds + buf * SHM_T + v_st(32 + sr, sc)) = st.v1;
    *(bf16x8*)(K_lds + buf * SHM_T + ATT_KSWZ(sr, sc * 2)) = st.k0; *(bf16x8*)(K_lds + buf * SHM_T + ATT_KSWZ(32 + sr, sc * 2)) = st.k1;
}
struct StgF { f32x4 k0a, k0b, v0a, v0b, k1a, k1b, v1a, v1b; };
__device__ __forceinline__ void load_cache(const Args& a, int j, int b, int h, int pb, int sr, int sc, StgF& s) {
    const size_t base = ((size_t)(j * BS + b) * PAST) * D + h * HD + sc; const float* ck = a.in[2] + base; const float* cv = a.in[3] + base;
    const size_t o0 = (size_t)max(pb + sr, 0) * D, o1 = (size_t)(pb + 32 + sr) * D;
    s.k0a = *(const f32x4*)(ck + o0); s.k0b = *(const f32x4*)(ck + o0 + 4); s.v0a = *(const f32x4*)(cv + o0); s.v0b = *(const f32x4*)(cv + o0 + 4);
    s.k1a = *(const f32x4*)(ck + o1); s.k1b = *(const f32x4*)(ck + o1 + 4); s.v1a = *(const f32x4*)(cv + o1); s.v1b = *(const f32x4*)(cv + o1 + 4);
}
__device__ __forceinline__ bf16x8 cvt8r(const f32x4 x, const f32x4 y) { u32x4 w = {cvtpk(x.x, x.y), cvtpk(x.z, x.w), cvtpk(y.x, y.y), cvtpk(y.z, y.w)}; return *reinterpret_cast<bf16x8*>(&w); }
__device__ __forceinline__ void write_kvf(char* V_lds, char* K_lds, int buf, int sr, int sc, const StgF& s) {
    *(bf16x8*)(V_lds + buf * SHM_T + v_st(sr, sc)) = cvt8r(s.v0a, s.v0b); *(bf16x8*)(V_lds + buf * SHM_T + v_st(32 + sr, sc)) = cvt8r(s.v1a, s.v1b);
    *(bf16x8*)(K_lds + buf * SHM_T + ATT_KSWZ(sr, sc * 2)) = cvt8r(s.k0a, s.k0b); *(bf16x8*)(K_lds + buf * SHM_T + ATT_KSWZ(32 + sr, sc * 2)) = cvt8r(s.k1a, s.k1b);
}
template <bool SAMPLE> __device__ __forceinline__ void attn_item(const Args& a, unsigned char* shm, int j, int b, int h, int q0) {
    const int tid = fresh_tid(), wid = __builtin_amdgcn_readfirstlane(tid >> 6), lane = tid & 63, r32 = lane & 31, hi = lane >> 5;
    char* V_lds = (char*)shm; char* K_lds = (char*)shm + 2 * SHM_T; volatile LAS unsigned* flags = (volatile LAS unsigned*)((LAS unsigned char*)shm + 4 * SHM_T);
    const bf16* QB = (const bf16*)(a.ws + WS_QB); const bf16* GB = (const bf16*)(a.ws + WS_GB); bf16* OG = (bf16*)(a.ws + WS_OG);
    const int qbw = SAMPLE ? PAST : q0 + 32 * wid;
    const int qpos = qbw + r32;
    const size_t qrow = SAMPLE ? (size_t)(MP + b * TS + r32) : (size_t)(b * TP + qpos);
    bool done = SAMPLE ? (wid != 0) : false;
    bf16x8 qr[8];
#pragma unroll
    for (int d0 = 0; d0 < 8; ++d0) qr[d0] = *(const bf16x8*)(QB + hm((int)qrow, h) + d0 * 16 + hi * 8);
    f32x16 o[4] = {}; float C = 1.f;
    const int ptop = SAMPLE ? PAST - 32 : q0 + 192, ntiles = SAMPLE ? 33 : ptop / 64 + 1;
    const int sr = tid >> 4, sc = (tid & 15) * 8, vb0 = (int)(uintptr_t)V_lds + v_rd_base(lane);
    if (tid < 16) flags[tid] = 0u;
    Stg st; load_kv<SAMPLE>(a, j, b, h, ptop, sr, sc, st);
    write_kv(V_lds, K_lds, 0, sr, sc, st);
    StgF sf;
    if (SAMPLE) load_cache(a, j, b, h, ptop - 64, sr, sc, sf); else if (ntiles > 1) load_kv<SAMPLE>(a, j, b, h, ptop - 64, sr, sc, st);
    WG_BAR();
    for (int ti = 0;; ++ti) {
        const int pb = ptop - 64 * ti, cur = ti & 1;
        if (!done && pb < qbw + 31) {
            f32x16 p0, p1;
            qkt(p0, p1, K_lds + cur * SHM_T, qr, r32, hi);
            if (pb + 63 < qbw && (!SAMPLE || pb >= 0)) { C = sb_half<SAMPLE, false>(p1, C, pb + 32, qpos, hi); C = sb_half<SAMPLE, false>(p0, C, pb, qpos, hi); }
            else { C = sb_half<SAMPLE, true>(p1, C, pb + 32, qpos, hi); C = sb_half<SAMPLE, true>(p0, C, pb, qpos, hi); }
            bf16x8 pa0, pa1, pa2, pa3;
            ATT_PK4(p0, 0, pa0); ATT_PK4(p0, 8, pa1); ATT_PK4(p1, 0, pa2); ATT_PK4(p1, 8, pa3);
            const int vb = vb0 + cur * SHM_T;
            pv_one<0>(o[0], vb, pa0, pa1, pa2, pa3); pv_one<1>(o[1], vb, pa0, pa1, pa2, pa3); pv_one<2>(o[2], vb, pa0, pa1, pa2, pa3); pv_one<3>(o[3], vb, pa0, pa1, pa2, pa3);
            done = __all(C < SB_EXIT_LIN);
        }
        const bool more = ti + 1 < ntiles;
        if (SAMPLE) { if (more) write_kvf(V_lds, K_lds, cur ^ 1, sr, sc, sf); load_cache(a, j, b, h, ptop - 64 * min(ti + 2, ntiles - 1), sr, sc, sf); }
        else { if (more) write_kv(V_lds, K_lds, cur ^ 1, sr, sc, st);
            if (ti + 2 < ntiles) load_kv<SAMPLE>(a, j, b, h, ptop - 64 * (ti + 2), sr, sc, st); }
        if (lane == 0) flags[cur * 8 + wid] = done ? 1u : 0u;
        WG_BAR();
        if (!more) break;
        unsigned nd = 0;
#pragma unroll
        for (int w = 0; w < 8; ++w) nd += flags[cur * 8 + w];
        if (nd == 8u) break;
    }
    if (!SAMPLE || wid == 0) {
        const size_t row0 = SAMPLE ? (size_t)(MP + b * TS) : (size_t)(b * TP + qbw);
        u32x4 egt[8], ekk[8], evv[8];
#pragma unroll
        for (int i = 0; i < 8; ++i) { const size_t ho = hm((int)row0 + 4 * i + (lane >> 4), h) + (lane & 15) * 8;
            egt[i] = *(const u32x4*)(GB + ho); if (SAMPLE) { ekk[i] = *(const u32x4*)((const bf16*)(a.ws + WS_KB) + ho); evv[i] = *(const u32x4*)((const bf16*)(a.ws + WS_VB) + ho); } }
        float* ol = (float*)(shm + wid * 16384);
#pragma unroll
        for (int d0 = 0; d0 < 4; ++d0)
#pragma unroll
            for (int g = 0; g < 4; ++g) *(f32x4*)(ol + r32 * 128 + (((8 * d0 + 2 * g + hi) ^ r32) << 2)) = (f32x4){o[d0][4 * g + 0], o[d0][4 * g + 1], o[d0][4 * g + 2], o[d0][4 * g + 3]};
        asm volatile("s_waitcnt lgkmcnt(0)" ::: "memory");
#pragma unroll
        for (int i = 0; i < 8; ++i) { const int q = 4 * i + (lane >> 4), c = (lane & 15) * 8; const size_t idx = (row0 + q) * D + h * HD + c;
            const u32x4 gt = egt[i]; const f32x4 x0 = *(const f32x4*)(ol + q * 128 + ((((c >> 2)) ^ q) << 2)), x1 = *(const f32x4*)(ol + q * 128 + ((((c >> 2) + 1) ^ q) << 2));
            u32x4 w; w.x = cvtpk(x0.x * bflo(gt.x), x0.y * bfhi(gt.x)); w.y = cvtpk(x0.z * bflo(gt.y), x0.w * bfhi(gt.y)); w.z = cvtpk(x1.x * bflo(gt.z), x1.y * bfhi(gt.z)); w.w = cvtpk(x1.z * bflo(gt.w), x1.w * bfhi(gt.w));
            *(u32x4*)(OG + idx) = w;
            if (SAMPLE) {
                const u32x4 kk = ekk[i], vv = evv[i];
                const size_t so = (size_t)j * MS * D + (idx - (size_t)MP * D); float* ko = a.out + O_KS + so; float* vo = a.out + O_VS + so;
                *(f32x4*)ko = (f32x4){bflo(kk.x), bfhi(kk.x), bflo(kk.y), bfhi(kk.y)}; *(f32x4*)(ko + 4) = (f32x4){bflo(kk.z), bfhi(kk.z), bflo(kk.w), bfhi(kk.w)};
                *(f32x4*)vo = (f32x4){bflo(vv.x), bfhi(vv.x), bflo(vv.y), bfhi(vv.y)}; *(f32x4*)(vo + 4) = (f32x4){bflo(vv.z), bfhi(vv.z), bflo(vv.w), bfhi(vv.w)}; } }
    }
    __syncthreads();
}
__device__ __forceinline__ void attn_item3(const Args& a, unsigned char* shm, int j, int b, int h, int q0) {
    const int tid = fresh_tid(), wid = __builtin_amdgcn_readfirstlane(tid >> 6), lane = tid & 63, r32 = lane & 31, hi = lane >> 5;
    volatile LAS unsigned* flags = (volatile LAS unsigned*)((LAS unsigned char*)shm + 6 * SHM_T);
    const bf16* QB = (const bf16*)(a.ws + WS_QB); const bf16* GB = (const bf16*)(a.ws + WS_GB); bf16* OG = (bf16*)(a.ws + WS_OG);
    const int qbw = q0 + 32 * wid, qpos = qbw + r32;
    const size_t qrow = (size_t)(b * TP + qpos);
    bool done = false;
    bf16x8 qr[8];
#pragma unroll
    for (int d0 = 0; d0 < 8; ++d0) qr[d0] = *(const bf16x8*)(QB + hm((int)qrow, h) + d0 * 16 + hi * 8);
    f32x16 o[4] = {}; float C = 1.f;
    const int ptop = q0 + 192, ntiles = ptop / 64 + 1;
    const int vbl = (int)(uintptr_t)shm + v_rd_base(lane);
    if (tid < 16) flags[tid] = 0u;
    const bool isK = wid >= 4; const int cb0 = 4 * (wid & 3);
    unsigned offs[4];
#pragma unroll
    for (int i = 0; i < 4; ++i) { const int cb = cb0 + i; int row, col;
        if (isK) { row = cb * 4 + (lane >> 4); const int colB = ((lane & 15) * 16) ^ ((row & 7) << 4); col = colB >> 1; }
        else { const int sb = cb * 2 + (lane >> 5), kk = (sb >> 2) * 8 + ((lane & 31) >> 2); row = (kk & ~0xC) | ((kk & 4) << 1) | ((kk & 8) >> 1); col = (sb & 3) * 32 + (lane & 3) * 8; }
        offs[i] = (unsigned)(row * HD + col); }
    const bf16* src0 = (isK ? (const bf16*)(a.ws + WS_KB) : (const bf16*)(a.ws + WS_VB)) + hm(b * TP, h);
    unsigned char* dst0 = shm + (isK ? SHM_T : 0) + cb0 * 1024;
#define ATT_DMA(slot, pb_) do { const bf16* s_ = src0 + (size_t)(pb_) * HD; LAS unsigned* d_ = (LAS unsigned*)(LAS unsigned char*)(dst0 + (slot) * 2 * SHM_T); \
        _Pragma("unroll") for (int i_ = 0; i_ < 4; ++i_) __builtin_amdgcn_global_load_lds((const unsigned*)(s_ + offs[i_]), d_ + i_ * 256, 16, 0, 0); } while (0)
    ATT_DMA(0, ptop);
    if (ntiles > 1) ATT_DMA(1, ptop - 64);
    int s = 0;
    for (int ti = 0; ti < ntiles; ++ti) {
        const int pb = ptop - 64 * ti;
        if (ti + 1 < ntiles) asm volatile("s_waitcnt vmcnt(4)" ::: "memory"); else asm volatile("s_waitcnt vmcnt(0)" ::: "memory");
        WG_BAR();
        if (ti > 0) { unsigned nd = 0;
#pragma unroll
            for (int w = 0; w < 8; ++w) nd += flags[((ti - 1) & 1) * 8 + w];
            if (nd == 8u) break; }
        if (ti + 2 < ntiles) { const int s2 = s >= 1 ? s - 1 : 2; ATT_DMA(s2, pb - 128); }
        if (!done && pb < qbw + 31) {
            f32x16 p0, p1;
            qkt(p0, p1, (const char*)shm + (2 * s + 1) * SHM_T, qr, r32, hi);
            if (pb + 63 < qbw) { C = sb_half<false, false>(p1, C, pb + 32, qpos, hi); C = sb_half<false, false>(p0, C, pb, qpos, hi); }
            else { C = sb_half<false, true>(p1, C, pb + 32, qpos, hi); C = sb_half<false, true>(p0, C, pb, qpos, hi); }
            bf16x8 pa0, pa1, pa2, pa3;
            ATT_PK4(p0, 0, pa0); ATT_PK4(p0, 8, pa1); ATT_PK4(p1, 0, pa2); ATT_PK4(p1, 8, pa3);
            const int vb = vbl + 2 * s * SHM_T;
            pv_one<0>(o[0], vb, pa0, pa1, pa2, pa3); pv_one<1>(o[1], vb, pa0, pa1, pa2, pa3); pv_one<2>(o[2], vb, pa0, pa1, pa2, pa3); pv_one<3>(o[3], vb, pa0, pa1, pa2, pa3);
            done = __all(C < SB_EXIT_LIN);
        }
        if (lane == 0) flags[(ti & 1) * 8 + wid] = done ? 1u : 0u;
        s = s == 2 ? 0 : s + 1;
    }
#undef ATT_DMA
    u32x4 egt[8], ekk[8], evv[8];
#pragma unroll
    for (int i = 0; i < 8; ++i) { const size_t ho = hm(b * TP + qbw + 4 * i + (lane >> 4), h) + (lane & 15) * 8;
        egt[i] = *(const u32x4*)(GB + ho); ekk[i] = *(const u32x4*)((const bf16*)(a.ws + WS_KB) + ho); evv[i] = *(const u32x4*)((const bf16*)(a.ws + WS_VB) + ho); }
    asm volatile("s_waitcnt vmcnt(0)" ::: "memory");
    WG_BAR();
    {
        float* ol = (float*)(shm + wid * 16384);
#pragma unroll
        for (int d0 = 0; d0 < 4; ++d0)
#pragma unroll
            for (int g = 0; g < 4; ++g) *(f32x4*)(ol + r32 * 128 + (((8 * d0 + 2 * g + hi) ^ r32) << 2)) = (f32x4){o[d0][4 * g + 0], o[d0][4 * g + 1], o[d0][4 * g + 2], o[d0][4 * g + 3]};
        asm volatile("s_waitcnt lgkmcnt(0)" ::: "memory");
        const size_t row0 = (size_t)(b * TP + qbw);
#pragma unroll
        for (int i = 0; i < 8; ++i) { const int q = 4 * i + (lane >> 4), c = (lane & 15) * 8; const size_t idx = (row0 + q) * D + h * HD + c;
            const u32x4 gt = egt[i]; const f32x4 x0 = *(const f32x4*)(ol + q * 128 + ((((c >> 2)) ^ q) << 2)), x1 = *(const f32x4*)(ol + q * 128 + ((((c >> 2) + 1) ^ q) << 2));
            u32x4 w; w.x = cvtpk(x0.x * bflo(gt.x), x0.y * bfhi(gt.x)); w.y = cvtpk(x0.z * bflo(gt.y), x0.w * bfhi(gt.y)); w.z = cvtpk(x1.x * bflo(gt.z), x1.y * bfhi(gt.z)); w.w = cvtpk(x1.z * bflo(gt.w), x1.w * bfhi(gt.w));
            *(u32x4*)(OG + idx) = w;
            const u32x4 kk = ekk[i], vv = evv[i];
            float* ko = a.out + O_KP + (size_t)j * MP * D + idx; float* vo = a.out + O_VP + (size_t)j * MP * D + idx;
            *(f32x4*)ko = (f32x4){bflo(kk.x), bfhi(kk.x), bflo(kk.y), bfhi(kk.y)}; *(f32x4*)(ko + 4) = (f32x4){bflo(kk.z), bfhi(kk.z), bflo(kk.w), bfhi(kk.w)};
            *(f32x4*)vo = (f32x4){bflo(vv.x), bfhi(vv.x), bflo(vv.y), bfhi(vv.y)}; *(f32x4*)(vo + 4) = (f32x4){bflo(vv.z), bfhi(vv.z), bflo(vv.w), bfhi(vv.w)}; }
    }
    __syncthreads();
}
}
__device__ __forceinline__ void ph_attn(const Args& a, unsigned char* shm, int bid, int nblk, int layer) {
    const int j = layer >> 1;
    for (int it = bid; it < BP * NH * (TP / 256) + BS * NH; it += nblk) {
        if (it < BP * NH * (TP / 256)) att::attn_item3(a, shm, j, it >> 8, (it >> 4) & 15, (it & 15) * 256);
        else { const int u = it - BP * NH * (TP / 256); att::attn_item<true>(a, shm, j, u >> 4, u & 15, 0); }
    }
}


namespace hg {
using bf16x8 = __attribute__((ext_vector_type(8))) short;
using s16x4  = __attribute__((ext_vector_type(4))) short;
constexpr int T_QH = 0, T_KD = 8192, T_KT = 16384, T_V = 24576, T_TOT = 32768, T_DEC = T_TOT + 8 * 128 * 4, BUFSZ = T_DEC + 512, T_P = 2 * BUFSZ, PST = 80, T_O = T_P + 32 * PST, OST = 132, T_END = T_O + 32 * OST * 4;
static_assert(BUFSZ % 16 == 0 && T_P % 16 == 0 && T_O % 16 == 0 && T_END <= 131072, "hgrn LDS map");
constexpr int SEG = 1024, NSEG = TP / SEG;
constexpr size_t HL_DG = (size_t)BP * NH * (NSEG - 1) * HD * HD * 4;
__device__ __forceinline__ unsigned off_b(unsigned row, unsigned ch) { return 256u * row + 16u * (ch ^ (((row & 3) << 2) | ((row >> 2) & 3))); }
__device__ __forceinline__ unsigned row_read_addr_16(unsigned lane, unsigned rb, unsigned s) { return off_b((lane & 15) + 16 * rb, 4 * s + (lane >> 4)); }
__device__ __forceinline__ unsigned tr_read_addr_16(unsigned lane, unsigned c, unsigned t) {
    const unsigned g = lane >> 4, q = (lane & 15) >> 2, p = lane & 3; return off_b(8 * g + 4 * t + q, 2 * c + (p >> 1)) + 8 * (p & 1); }
__device__ __forceinline__ unsigned cvtpk(float lo, float hi) { unsigned r; asm volatile("v_cvt_pk_bf16_f32 %0, %1, %2" : "=v"(r) : "v"(lo), "v"(hi)); return r; }
__device__ __forceinline__ s16x4 tr_ld(unsigned addr) { s16x4 r; asm volatile("ds_read_b64_tr_b16 %0, %1" : "=&v"(r) : "v"(addr) : "memory"); return r; }
#define HG_LGKM0() do { asm volatile("s_waitcnt lgkmcnt(0)" ::: "memory"); __builtin_amdgcn_sched_barrier(0); } while (0)
#define HG_CAT(L, H) (bf16x8){L[0], L[1], L[2], L[3], H[0], H[1], H[2], H[3]}
__device__ __forceinline__ f32x4 mfma16(bf16x8 a, bf16x8 b, f32x4 c) { return __builtin_amdgcn_mfma_f32_16x16x32_bf16(a, b, c, 0, 0, 0); }

typedef _Float16 h16x2 __attribute__((ext_vector_type(2)));
struct Pre { unsigned lh[4]; unsigned qv[4]; u32x4 vv, gv; };
template <bool FULL> __device__ __forceinline__ void load_chunk(const Args& a, int r0, int h, int tid, Pre& p) {
    const int lane = tid & 63, w = tid >> 6;
    const bf16* QB = (const bf16*)(a.ws + WS_QB); const bf16* VB = (const bf16*)(a.ws + WS_VB); const bf16* GB = (const bf16*)(a.ws + WS_GB); const unsigned short* LF = (const unsigned short*)(a.ws + WS_LF);
#pragma unroll
    for (int i = 0; i < 4; ++i) { const size_t idx = hm(r0 + 4 * w + i, h) + 2 * lane; p.lh[i] = *(const unsigned*)(LF + idx); if (FULL) p.qv[i] = *(const unsigned*)(QB + idx); }
    const size_t vidx = hm(r0 + (tid >> 4), h) + 8 * (tid & 15);
    p.vv = *(const u32x4*)(VB + vidx); if (FULL) p.gv = *(const u32x4*)(GB + vidx);
}
struct StA { f32x2 l[4], c[4]; unsigned qv[4]; };
template <bool FULL> __device__ __forceinline__ void stageA(unsigned char* bufp, int tid, const Pre& p, StA& sa, u32x4& gv) {
    const int lane = tid & 63, w = __builtin_amdgcn_readfirstlane(tid >> 6);
#pragma unroll
    for (int i = 0; i < 4; ++i) { const h16x2 lv = __builtin_bit_cast(h16x2, p.lh[i]); sa.l[i] = (f32x2){(float)lv.x, (float)lv.y} * LOG2E; if (FULL) sa.qv[i] = p.qv[i]; }
    if (FULL) gv = p.gv;
    sa.c[0] = sa.l[0]; sa.c[1] = sa.c[0] + sa.l[1]; sa.c[2] = sa.c[1] + sa.l[2]; sa.c[3] = sa.c[2] + sa.l[3];
    *(f32x2*)(bufp + T_TOT + (w * 128 + 2 * lane) * 4) = sa.c[3];
    *(u32x4*)(bufp + T_V + off_b(tid >> 4, tid & 15)) = p.vv;
}
template <bool FULL> __device__ __forceinline__ void stageB(unsigned char* bufp, int tid, const StA& sa, f32x2& dsum) {
    const int lane = tid & 63, w = __builtin_amdgcn_readfirstlane(tid >> 6);
    f32x2 pre = {0.f, 0.f}, bl = {0.f, 0.f};
#pragma unroll
    for (int ww = 0; ww < 8; ++ww) { const f32x2 t = *(const f32x2*)(bufp + T_TOT + (ww * 128 + 2 * lane) * 4); if (ww < w) pre += t; bl += t; }
    f32x2 f[4];
#pragma unroll
    for (int i = 0; i < 4; ++i) { f[i].x = __builtin_amdgcn_exp2f(sa.l[i].x); f[i].y = __builtin_amdgcn_exp2f(sa.l[i].y); }
    { const f32x2 er = bl - pre - sa.c[3]; f32x2 kt = {__builtin_amdgcn_exp2f(er.x), __builtin_amdgcn_exp2f(er.y)};
#pragma unroll
        for (int i = 3; i >= 0; --i) { const f32x2 k = (f32x2){1.0f, 1.0f} - f[i];
            *(unsigned*)(bufp + T_KT + off_b(4 * w + i, lane >> 2) + (lane & 3) * 4) = cvtpk(k.x * kt.x, k.y * kt.y);
            kt = kt * f[i]; } }
    if (FULL) { f32x2 qh = {__builtin_amdgcn_exp2f(pre.x), __builtin_amdgcn_exp2f(pre.y)};
#pragma unroll
        for (int i = 0; i < 4; ++i) { const f32x2 b = pre + sa.c[i], k = (f32x2){1.0f, 1.0f} - f[i]; const unsigned addr = off_b(4 * w + i, lane >> 2) + (lane & 3) * 4;
            qh = qh * f[i];
            *(unsigned*)(bufp + T_QH + addr) = cvtpk(bflo(sa.qv[i]) * qh.x, bfhi(sa.qv[i]) * qh.y);
            *(unsigned*)(bufp + T_KD + addr) = cvtpk(k.x * __builtin_amdgcn_exp2f(fminf(-b.x, 115.f)), k.y * __builtin_amdgcn_exp2f(fminf(-b.y, 115.f))); } }
    if (w == 0) { f32x2 e; e.x = __builtin_amdgcn_exp2f(bl.x); e.y = __builtin_amdgcn_exp2f(bl.y); *(f32x2*)(bufp + T_DEC + 2 * lane * 4) = e; }
    dsum += bl;
}
__device__ __forceinline__ bf16x8 load_vfrag(unsigned char* bufp, int tid) {
    const int lane = tid & 63, w = __builtin_amdgcn_readfirstlane(tid >> 6); const unsigned lds0 = (unsigned)(uintptr_t)bufp;
    const s16x4 vlo = tr_ld(lds0 + T_V + tr_read_addr_16(lane, w, 0)), vhi = tr_ld(lds0 + T_V + tr_read_addr_16(lane, w, 1));
    HG_LGKM0();
    return HG_CAT(vlo, vhi);
}
__device__ __forceinline__ void stageC(unsigned char* shm, unsigned char* bufp, int tid, const f32x4 (&S)[8], f32x4 (&o)[2]) {
    const int lane = tid & 63, w = __builtin_amdgcn_readfirstlane(tid >> 6), g = lane >> 4, l15 = lane & 15;
    o[0] = (f32x4){0.f, 0.f, 0.f, 0.f}; o[1] = (f32x4){0.f, 0.f, 0.f, 0.f};
    if (w < 3) {
        const int rb = w > 0 ? 1 : 0, cb = w == 2 ? 1 : 0; f32x4 sc = {0.f, 0.f, 0.f, 0.f};
#pragma unroll
        for (int ks = 0; ks < 4; ++ks) { const bf16x8 A = *(const bf16x8*)(bufp + T_QH + row_read_addr_16(lane, rb, ks)), B = *(const bf16x8*)(bufp + T_KD + row_read_addr_16(lane, cb, ks)); sc = mfma16(A, B, sc); }
#pragma unroll
        for (int i = 0; i < 4; ++i) { const int tl = 4 * g + i; const float v = (rb != cb || l15 <= tl) ? sc[i] : 0.f;
            *(unsigned short*)(shm + T_P + (16 * rb + tl) * PST + (16 * cb + l15) * 2) = (unsigned short)f2bf(v); }
    }
#pragma unroll
    for (int ks = 0; ks < 4; ++ks) {
        u32x4 bw = {cvtpk(S[2 * ks][0], S[2 * ks][1]), cvtpk(S[2 * ks][2], S[2 * ks][3]), cvtpk(S[2 * ks + 1][0], S[2 * ks + 1][1]), cvtpk(S[2 * ks + 1][2], S[2 * ks + 1][3])};
        const bf16x8 Bf = *reinterpret_cast<bf16x8*>(&bw);
#pragma unroll
        for (int rb = 0; rb < 2; ++rb) { const unsigned t = l15 + 16 * rb;
            const u32x2 alo = *(const u32x2*)(bufp + T_QH + off_b(t, 4 * ks + (g >> 1)) + 8 * (g & 1)), ahi = *(const u32x2*)(bufp + T_QH + off_b(t, 4 * ks + 2 + (g >> 1)) + 8 * (g & 1));
            u32x4 aw = {alo.x, alo.y, ahi.x, ahi.y}; o[rb] = mfma16(*reinterpret_cast<bf16x8*>(&aw), Bf, o[rb]); }
    }
}
template <bool FULL> __device__ __forceinline__ void stageD(unsigned char* shm, unsigned char* bufp, int tid, f32x4 (&S)[8], f32x4 (&o)[2]) {
    const int lane = tid & 63, w = __builtin_amdgcn_readfirstlane(tid >> 6), g = lane >> 4, l15 = lane & 15; const unsigned lds0 = (unsigned)(uintptr_t)bufp;
    const bf16x8 vf = load_vfrag(bufp, tid);
    if (FULL) {
#pragma unroll
        for (int rb = 0; rb < 2; ++rb) { const bf16x8 A = *(const bf16x8*)(shm + T_P + (l15 + 16 * rb) * PST + 16 * g); o[rb] = mfma16(A, vf, o[rb]); }
#pragma unroll
        for (int rb = 0; rb < 2; ++rb)
#pragma unroll
            for (int i = 0; i < 4; ++i) *(float*)(shm + T_O + ((16 * rb + 4 * g + i) * OST + 16 * w + l15) * 4) = o[rb][i];
    }
#pragma unroll
    for (int kt = 0; kt < 8; kt += 2) {
        const s16x4 k0l = tr_ld(lds0 + T_KT + tr_read_addr_16(lane, kt, 0)), k0h = tr_ld(lds0 + T_KT + tr_read_addr_16(lane, kt, 1));
        const s16x4 k1l = tr_ld(lds0 + T_KT + tr_read_addr_16(lane, kt + 1, 0)), k1h = tr_ld(lds0 + T_KT + tr_read_addr_16(lane, kt + 1, 1));
        const f32x4 d0 = *(const f32x4*)(bufp + T_DEC + (16 * kt + 4 * g) * 4), d1 = *(const f32x4*)(bufp + T_DEC + (16 * (kt + 1) + 4 * g) * 4);
        HG_LGKM0();
        S[kt] = mfma16(HG_CAT(k0l, k0h), vf, S[kt] * d0); S[kt + 1] = mfma16(HG_CAT(k1l, k1h), vf, S[kt + 1] * d1);
    }
}
__device__ __forceinline__ void stageE(const Args& a, unsigned char* shm, int tid, int r0, int h, int jl, const u32x4 gv) {
    const int vrow = tid >> 4, vch = tid & 15, c0 = 8 * vch; const float* hw = a.in[10] + jl * HD + c0; bf16* OG = (bf16*)(a.ws + WS_OG);
    const f32x4 x0 = *(const f32x4*)(shm + T_O + (vrow * OST + c0) * 4), x1 = *(const f32x4*)(shm + T_O + (vrow * OST + c0 + 4) * 4);
    float ss = (x0.x * x0.x + x0.y * x0.y) + (x0.z * x0.z + x0.w * x0.w) + (x1.x * x1.x + x1.y * x1.y) + (x1.z * x1.z + x1.w * x1.w);
    ss += __shfl_xor(ss, 1); ss += __shfl_xor(ss, 2); ss += __shfl_xor(ss, 4); ss += __shfl_xor(ss, 8);
    const float rn = __builtin_amdgcn_rsqf(ss * (1.0f / HD) + EPS); const f32x4 h0 = *(const f32x4*)hw, h1 = *(const f32x4*)(hw + 4);
    u32x4 wv;
    wv.x = cvtpk(x0.x * rn * h0.x * bflo(gv.x), x0.y * rn * h0.y * bfhi(gv.x)); wv.y = cvtpk(x0.z * rn * h0.z * bflo(gv.y), x0.w * rn * h0.w * bfhi(gv.y));
    wv.z = cvtpk(x1.x * rn * h1.x * bflo(gv.z), x1.y * rn * h1.y * bfhi(gv.z)); wv.w = cvtpk(x1.z * rn * h1.z * bflo(gv.w), x1.w * rn * h1.w * bfhi(gv.w));
    *(u32x4*)(OG + (size_t)(r0 + vrow) * D + h * HD + c0) = wv;
}
template <bool FULL> __device__ __forceinline__ void run_chunks(const Args& a, unsigned char* shm, int r0, int nst, int h, int jl, f32x4 (&S)[8], f32x2& dsum, int tid) {
    Pre pA, pB; StA sa; u32x4 gvA = {0u, 0u, 0u, 0u}, gvB = {0u, 0u, 0u, 0u}; f32x4 o[2];
    load_chunk<FULL>(a, r0, h, tid, pA); if (nst > 1) load_chunk<FULL>(a, r0 + 32, h, tid, pB);
    stageA<FULL>(shm, tid, pA, sa, gvA); if (nst > 2) load_chunk<FULL>(a, r0 + 64, h, tid, pA);
    WG_BAR();
    stageB<FULL>(shm, tid, sa, dsum);
    WG_BAR();
#define HG_TURN(M, BC, BN, PN, GN, GE) do { const int m_ = (M); \
        if (FULL) { if (m_ > 0) stageE(a, shm, tid, r0 + 32 * (m_ - 1), h, jl, GE); stageC(shm, shm + (BC) * BUFSZ, tid, S, o); } \
        else stageD<false>(shm, shm + (BC) * BUFSZ, tid, S, o); \
        if (m_ + 1 < nst) { stageA<FULL>(shm + (BN) * BUFSZ, tid, PN, sa, GN); if (m_ + 3 < nst) load_chunk<FULL>(a, r0 + 32 * (m_ + 3), h, tid, PN); } \
        WG_BAR(); \
        if (FULL) stageD<true>(shm, shm + (BC) * BUFSZ, tid, S, o); \
        if (m_ + 1 < nst) stageB<FULL>(shm + (BN) * BUFSZ, tid, sa, dsum); \
        WG_BAR(); } while (0)
    for (int m = 0; m < nst; m += 2) {
        HG_TURN(m, 0, 1, pB, gvB, gvB);
        if (m + 1 < nst) HG_TURN(m + 1, 1, 0, pA, gvA, gvA);
    }
#undef HG_TURN
    if (FULL) stageE(a, shm, tid, r0 + 32 * (nst - 1), h, jl, ((nst - 1) & 1) ? gvB : gvA);
}
__device__ __forceinline__ size_t st_off(int kt, int i, int g, int w, int l15) { return (size_t)(16 * kt + 4 * g + i) * HD + 16 * w + l15; }

__device__ __forceinline__ void unit_pass1(const Args& a, unsigned char* shm, int jl, int b, int h, int seg) {
    const int tid = fresh_tid(), lane = tid & 63, w = __builtin_amdgcn_readfirstlane(tid >> 6), g = lane >> 4, l15 = lane & 15;
    f32x4 S[8];
#pragma unroll
    for (int kt = 0; kt < 8; ++kt) S[kt] = (f32x4){0.f, 0.f, 0.f, 0.f};
    f32x2 dsum = {0.f, 0.f};
    run_chunks<false>(a, shm, b * TP + seg * SEG, SEG / 32, h, jl, S, dsum, tid);
    float* L = (float*)(a.ws + WS_HL) + (size_t)((b * NH + h) * (NSEG - 1) + seg) * HD * HD;
#pragma unroll
    for (int kt = 0; kt < 8; ++kt)
#pragma unroll
        for (int i = 0; i < 4; ++i) L[st_off(kt, i, g, w, l15)] = S[kt][i];
    if (w == 0) *(f32x2*)((float*)(a.ws + WS_HL + HL_DG) + (size_t)((b * NH + h) * (NSEG - 1) + seg) * HD + 2 * lane) = dsum;
}
__device__ __forceinline__ void unit_pass2(const Args& a, unsigned char* shm, int jl, bool prompt, int b, int h, int seg) {
    const int tid = fresh_tid(), lane = tid & 63, w = __builtin_amdgcn_readfirstlane(tid >> 6), g = lane >> 4, l15 = lane & 15;
    f32x4 S[8];
#pragma unroll
    for (int kt = 0; kt < 8; ++kt) S[kt] = (f32x4){0.f, 0.f, 0.f, 0.f};
    if (prompt) {
        for (int sp = 0; sp < seg; ++sp) {
            const float* L = (const float*)(a.ws + WS_HL) + (size_t)((b * NH + h) * (NSEG - 1) + sp) * HD * HD;
            const float* Dg = (const float*)(a.ws + WS_HL + HL_DG) + (size_t)((b * NH + h) * (NSEG - 1) + sp) * HD;
#pragma unroll
            for (int kt = 0; kt < 8; ++kt) { const f32x4 dg = *(const f32x4*)(Dg + 16 * kt + 4 * g);
#pragma unroll
                for (int i = 0; i < 4; ++i) S[kt][i] = S[kt][i] * __builtin_amdgcn_exp2f(dg[i]) + L[st_off(kt, i, g, w, l15)]; }
        }
    } else {
        const float* S0 = a.in[4] + ((size_t)(jl * BS + b) * NH + h) * HD * HD;
#pragma unroll
        for (int kt = 0; kt < 8; ++kt)
#pragma unroll
            for (int i = 0; i < 4; ++i) S[kt][i] = S0[st_off(kt, i, g, w, l15)];
    }
    for (int u = tid; u < 32 * PST / 4; u += 512) ((unsigned*)(shm + T_P))[u] = 0u;
    f32x2 dsum = {0.f, 0.f};
    const int nst = prompt ? SEG / 32 : TS / 32, r0 = prompt ? b * TP + seg * SEG : MP + b * TS;
    run_chunks<true>(a, shm, r0, nst, h, jl, S, dsum, tid);
    if (!prompt || seg == NSEG - 1) {
        float* So = prompt ? a.out + O_SP + ((size_t)(jl * BP + b) * NH + h) * HD * HD : a.out + O_SS + ((size_t)(jl * BS + b) * NH + h) * HD * HD;
#pragma unroll
        for (int kt = 0; kt < 8; ++kt)
#pragma unroll
            for (int i = 0; i < 4; ++i) So[st_off(kt, i, g, w, l15)] = S[kt][i];
    }
    __syncthreads();
}
}
__device__ __forceinline__ void ph_hgrn1(const Args& a, unsigned char* shm, int bid, int nblk, int layer) {
    for (int it = bid; it < BP * NH * (hg::NSEG - 1); it += nblk) { const int seg = it % (hg::NSEG - 1), bh = it / (hg::NSEG - 1); hg::unit_pass1(a, shm, layer >> 1, bh / NH, bh % NH, seg); }
}
__device__ __forceinline__ void ph_hgrn2(const Args& a, unsigned char* shm, int bid, int nblk, int layer) {
    for (int it = bid; it < BP * NH * hg::NSEG + BS * NH; it += nblk) {
        if (it < BP * NH * hg::NSEG) { const int seg = it % hg::NSEG, bh = it / hg::NSEG; hg::unit_pass2(a, shm, layer >> 1, true, bh / NH, bh % NH, seg); }
        else { const int u = it - BP * NH * hg::NSEG; hg::unit_pass2(a, shm, layer >> 1, false, u / NH, u % NH, 0); }
    }
}


#define EPI_BAR() do { asm volatile("s_waitcnt lgkmcnt(0)" ::: "memory"); __builtin_amdgcn_s_barrier(); asm volatile("" ::: "memory"); } while (0)
__device__ __forceinline__ u32x4 pack8(const f32x4 a, const f32x4 b) { u32x4 w; w.x = pg8::cvt_pk_bf16(a.x, a.y); w.y = pg8::cvt_pk_bf16(a.z, a.w); w.z = pg8::cvt_pk_bf16(b.x, b.y); w.w = pg8::cvt_pk_bf16(b.z, b.w); return w; }
__device__ __forceinline__ f32x4 silu4(const f32x4 x) { f32x4 r; r.x = silu_f(x.x); r.y = silu_f(x.y); r.z = silu_f(x.z); r.w = silu_f(x.w); return r; }
__device__ __forceinline__ float sq4(const f32x4 x) { return (x.x * x.x + x.y * x.y) + (x.z * x.z + x.w * x.w); }

constexpr int RS_OFF = EPI_OFF + 8192, RS_TAG_OFF = RS_OFF + 1024;
static_assert(RS_TAG_OFF + 16 <= LDS_BYTES, "LDS map");
__device__ __forceinline__ const float* rstd_table(const float* ssq, float* scr, int row0, int nrows, int wr, int wc, int fr, int fq) {
    float* rs = scr + (RS_OFF - EPI_OFF) / 4; volatile LAS int* tag = (volatile LAS int*)((LAS float*)scr + (RS_TAG_OFF - EPI_OFF) / 4);
    if (__builtin_amdgcn_readfirstlane(*tag) != row0) {
        int t = (wr * 4 + wc) * 64 + fq * 16 + fr; asm volatile("" : "+v"(t));
        if (t < nrows) rs[t] = row_rstd(ssq, row0 + t);
        EPI_BAR();
        if (t == 0) *tag = row0;
        EPI_BAR();
    }
    return rs;
}
struct EpiG1Attn {
    static constexpr bool PERM = true, AFTER_DRAIN = false;
    const float* ssq; bf16* QB; bf16* KB; bf16* VB; bf16* GB; float* out; const float* qw; const float* kw; float* scr; int j;
    __device__ __forceinline__ void operator()(const pg8::f32x4 (&acc)[2][2][4][2], const pg8::Unit& u, int wr, int wc, int fr, int fq) const { run<2>(acc, u.pm * 256, u.pn, wr, wc, fr, fq, true); }
    template <int NAI> __device__ __forceinline__ void run(const pg8::f32x4 (&acc)[2][2][4][2], int row0, int pn, int wr, int wc, int fr, int fq, bool active) const {
        const int grp = pn >> 3, cD = 256 * (pn & 7) + 32 * wc + 8 * fq, rl0 = 64 * wr + fr, h0 = 2 * (pn & 7), dW = 32 * wc + 8 * fq; const bool prompt = row0 < MP;
        const float* rst = rstd_table(ssq, scr, row0, 128 * NAI, wr, wc, fr, fq);
        if (grp < 2) {
            if (active) {
#pragma unroll
                for (int ai = 0; ai < NAI; ++ai)
#pragma unroll
                    for (int m = 0; m < 4; ++m)
#pragma unroll
                        for (int bj = 0; bj < 2; ++bj) { float s = sq4(acc[ai][bj][m][0]) + sq4(acc[ai][bj][m][1]); s += __shfl_xor(s, 16); s += __shfl_xor(s, 32);
                            if (fq == 0) scr[((128 * ai + rl0 + 16 * m) * 2 + bj) * 4 + wc] = s; }
            }
            EPI_BAR();
            if (!active) return;
            const float* wp = (grp == 0 ? qw : kw) + 32 * wc + 8 * fq; const float gsc = grp == 0 ? QSCALE : 1.0f;
            const f32x4 w0 = *(const f32x4*)wp * gsc, w1 = *(const f32x4*)(wp + 4) * gsc;
            bf16* dst = grp == 0 ? QB : KB;
#pragma unroll
            for (int ai = 0; ai < NAI; ++ai)
#pragma unroll
                for (int m = 0; m < 4; ++m) { const int rl = 128 * ai + rl0 + 16 * m; const size_t ro = (size_t)(row0 + rl) * D + cD; const float r1 = rst[rl];
#pragma unroll
                    for (int bj = 0; bj < 2; ++bj) { const f32x4 t4 = *(const f32x4*)(scr + (rl * 2 + bj) * 4); const float tot = (t4.x + t4.y) + (t4.z + t4.w);
                        const float rn = r1 * __builtin_amdgcn_rsqf(r1 * r1 * tot * (1.0f / HD) + EPS);
                        const f32x4 v0 = acc[ai][bj][m][0] * rn * w0, v1 = acc[ai][bj][m][1] * rn * w1;
                        *(u32x4*)(dst + hm(row0 + rl, h0 + bj) + dW) = pack8(v0, v1);
                        }
                    asm volatile("" ::: "memory"); }
        } else if (grp == 2) {
            if (!active) return;
#pragma unroll
            for (int ai = 0; ai < NAI; ++ai)
#pragma unroll
                for (int m = 0; m < 4; ++m) { const int rl = 128 * ai + rl0 + 16 * m; const size_t ro = (size_t)(row0 + rl) * D + cD; const float r1 = rst[rl];
#pragma unroll
                    for (int bj = 0; bj < 2; ++bj) { const f32x4 v0 = acc[ai][bj][m][0] * r1, v1 = acc[ai][bj][m][1] * r1;
                        *(u32x4*)(VB + hm(row0 + rl, h0 + bj) + dW) = pack8(v0, v1);
                        }
                    asm volatile("" ::: "memory"); }
        } else {
            if (!active) return;
#pragma unroll
            for (int ai = 0; ai < NAI; ++ai)
#pragma unroll
                for (int m = 0; m < 4; ++m) { const int rl = 128 * ai + rl0 + 16 * m; const size_t ro = (size_t)(row0 + rl) * D + cD; const float r1 = rst[rl];
#pragma unroll
                    for (int bj = 0; bj < 2; ++bj) *(u32x4*)(GB + hm(row0 + rl, h0 + bj) + dW) = pack8(silu4(acc[ai][bj][m][0] * r1), silu4(acc[ai][bj][m][1] * r1));
                    asm volatile("" ::: "memory"); }
        }
    }
};
struct EpiG1Hgrn {
    static constexpr bool PERM = true, AFTER_DRAIN = false;
    const float* ssq; bf16* QB; unsigned short* LF; bf16* VB; bf16* GB; const float* oml; float* scr;
    __device__ __forceinline__ void operator()(const pg8::f32x4 (&acc)[2][2][4][2], const pg8::Unit& u, int wr, int wc, int fr, int fq) const { run<2>(acc, u.pm * 256, u.pn, wr, wc, fr, fq, true); }
    template <int NAI> __device__ __forceinline__ void run(const pg8::f32x4 (&acc)[2][2][4][2], int row0, int pn, int wr, int wc, int fr, int fq, bool active) const {
        const int grp = pn >> 3, cD = 256 * (pn & 7) + 32 * wc + 8 * fq, rl0 = 64 * wr + fr, h0 = 2 * (pn & 7), dW = 32 * wc + 8 * fq;
        const float* rst = rstd_table(ssq, scr, row0, 128 * NAI, wr, wc, fr, fq);
        if (!active) return;
        f32x4 om[2][2];
        if (grp == 1) {
#pragma unroll
            for (int bj = 0; bj < 2; ++bj) { om[bj][0] = *(const f32x4*)(oml + cD + 128 * bj); om[bj][1] = *(const f32x4*)(oml + cD + 128 * bj + 4); } }
#pragma unroll
        for (int ai = 0; ai < NAI; ++ai)
#pragma unroll
            for (int m = 0; m < 4; ++m) { const int rl = 128 * ai + rl0 + 16 * m; const size_t ro = (size_t)(row0 + rl) * D + cD; const float r1 = rst[rl];
#pragma unroll
                for (int bj = 0; bj < 2; ++bj) { const f32x4 v0 = acc[ai][bj][m][0] * r1, v1 = acc[ai][bj][m][1] * r1;
                    if (grp == 0) *(u32x4*)(QB + hm(row0 + rl, h0 + bj) + dW) = pack8(silu4(v0), silu4(v1));
                    else if (grp == 2) *(u32x4*)(VB + hm(row0 + rl, h0 + bj) + dW) = pack8(v0, v1);
                    else if (grp == 3) *(u32x4*)(GB + hm(row0 + rl, h0 + bj) + dW) = pack8(silu4(v0), silu4(v1));
                    else { f32x4 l0, l1;
#pragma unroll
                        for (int e = 0; e < 4; ++e) { const float m0 = om[bj][0][e], m1 = om[bj][1][e];
                            l0[e] = fminf(__builtin_amdgcn_logf(fmaxf(1.0f - m0, 1e-30f) + m0 * __builtin_amdgcn_rcpf(1.0f + __expf(-v0[e]))) * 0.6931471805599453f, 0.f); l1[e] = fminf(__builtin_amdgcn_logf(fmaxf(1.0f - m1, 1e-30f) + m1 * __builtin_amdgcn_rcpf(1.0f + __expf(-v1[e]))) * 0.6931471805599453f, 0.f); }
                        typedef _Float16 h16x2_ __attribute__((ext_vector_type(2)));
                        u32x4 lw; lw.x = __builtin_bit_cast(unsigned, (h16x2_){(_Float16)l0.x, (_Float16)l0.y}); lw.y = __builtin_bit_cast(unsigned, (h16x2_){(_Float16)l0.z, (_Float16)l0.w});
                        lw.z = __builtin_bit_cast(unsigned, (h16x2_){(_Float16)l1.x, (_Float16)l1.y}); lw.w = __builtin_bit_cast(unsigned, (h16x2_){(_Float16)l1.z, (_Float16)l1.w});
                        *(u32x4*)(LF + hm(row0 + rl, h0 + bj) + dW) = lw; } }
                asm volatile("" ::: "memory"); }
    }
};
template <bool BASE_F32, bool WRITE_Y> struct EpiG2 {
    static constexpr bool PERM = true, AFTER_DRAIN = false;
    const float* base_p; const float* base_s; float* out; bf16* XB; float* ssq; float* scr;
    __device__ __forceinline__ void operator()(const pg8::f32x4 (&acc)[2][2][4][2], const pg8::Unit& u, int wr, int wc, int fr, int fq) const { run<2>(acc, u.pm * 256, u.pn, wr, wc, fr, fq, true); }
    template <int NAI> __device__ __forceinline__ void run(const pg8::f32x4 (&acc)[2][2][4][2], int row0, int pn, int wr, int wc, int fr, int fq, bool active) const {
        const int c0 = 256 * pn + 32 * wc + 8 * fq, rl0 = 64 * wr + fr; const bool prompt = row0 < MP;
        if (active) {
            const size_t ro0 = (size_t)((prompt ? row0 : row0 - MP) + rl0) * D + c0;
            const float* bp = (prompt ? base_p : base_s) + ro0; float* op = (prompt ? out + O_YP : out + O_YS) + ro0;
            bf16* xb0 = XB + (size_t)(row0 + rl0) * D + c0;
            f32x4 pre[4][4]; u32x4 prh[4][2];
#define G2_LOAD(slot, q) do { const size_t ro_ = (size_t)(128 * ((q) >> 2) + 16 * ((q) & 3)) * D; \
                if (BASE_F32) { const float* p_ = bp + ro_; pre[slot][0] = *(const f32x4*)p_; pre[slot][1] = *(const f32x4*)(p_ + 4); pre[slot][2] = *(const f32x4*)(p_ + 128); pre[slot][3] = *(const f32x4*)(p_ + 132); } \
                else { prh[slot][0] = *(const u32x4*)(xb0 + ro_); prh[slot][1] = *(const u32x4*)(xb0 + ro_ + 128); } } while (0)
            G2_LOAD(0, 0); G2_LOAD(1, 1); if (NAI * 4 > 2) G2_LOAD(2, 2);
            asm volatile("" ::: "memory");
#pragma unroll
            for (int q = 0; q < 4 * NAI; ++q) { const int ai = q >> 2, m = q & 3, rl = 128 * ai + rl0 + 16 * m;
                if (q + 3 < 4 * NAI) G2_LOAD((q + 3) % 4, q + 3);
                asm volatile("" ::: "memory");
                const size_t ro = (size_t)(128 * ai + 16 * m) * D; bf16* xb = xb0 + ro;
                f32x4 b0, b1, b2, b3;
                if (BASE_F32) { b0 = pre[q % 4][0]; b1 = pre[q % 4][1]; b2 = pre[q % 4][2]; b3 = pre[q % 4][3]; }
                else { const u32x4 h0 = prh[q % 4][0], h1 = prh[q % 4][1];
                    b0 = (f32x4){bflo(h0.x), bfhi(h0.x), bflo(h0.y), bfhi(h0.y)}; b1 = (f32x4){bflo(h0.z), bfhi(h0.z), bflo(h0.w), bfhi(h0.w)};
                    b2 = (f32x4){bflo(h1.x), bfhi(h1.x), bflo(h1.y), bfhi(h1.y)}; b3 = (f32x4){bflo(h1.z), bfhi(h1.z), bflo(h1.w), bfhi(h1.w)}; }
                const f32x4 x0 = b0 + acc[ai][0][m][0], x1 = b1 + acc[ai][0][m][1], x2 = b2 + acc[ai][1][m][0], x3 = b3 + acc[ai][1][m][1];
                if (WRITE_Y) { float* o_ = op + ro; *(f32x4*)o_ = x0; *(f32x4*)(o_ + 4) = x1; *(f32x4*)(o_ + 128) = x2; *(f32x4*)(o_ + 132) = x3; }
                else { *(u32x4*)xb = pack8(x0, x1); *(u32x4*)(xb + 128) = pack8(x2, x3); }
                float s = (sq4(x0) + sq4(x1)) + (sq4(x2) + sq4(x3));
                s += __shfl_xor(s, 16); s += __shfl_xor(s, 32);
                if (fq == 0) scr[rl * 4 + wc] = s;
                asm volatile("" ::: "memory"); }
#undef G2_LOAD
        }
        EPI_BAR();
        if (!WRITE_Y && active && wc == 0 && fq == 0) {
#pragma unroll
            for (int ai = 0; ai < NAI; ++ai)
#pragma unroll
                for (int m = 0; m < 4; ++m) { const int rl = 128 * ai + rl0 + 16 * m; const f32x4 t4 = *(const f32x4*)(scr + rl * 4); ssq[(size_t)(row0 + rl) * 8 + pn] = (t4.x + t4.y) + (t4.z + t4.w); }
        }
    }
};

template <class Epi> __device__ __forceinline__ void skinny_unit(PG8_LAS unsigned char* lds, const bf16* A, const bf16* Bt, int K, const Epi& E, int row0, int pn) {
    using pg8::bf16x8; using pg8::f32x4;
    const int tid = fresh_tid(), wid = __builtin_amdgcn_readfirstlane(tid >> 6), lane = tid & 63, wr = wid >> 2, wc = wid & 3, fr = lane & 15, fq = lane >> 4;
    const int nt = K / 64;
    unsigned voffA, voffB[2];
    { int R, C; pg8::stage_rc(tid * 16, R, C); voffA = (unsigned)(R * K + C) * 2u; }
#pragma unroll
    for (int i = 0; i < 2; ++i) { int R, C; pg8::stage_rc(tid * 16 + i * 8192, R, C); const int Rb = (R & ~31) + pg8::perm32(R & 31); voffB[i] = (unsigned)(Rb * K + C) * 2u; }
    const char* gA = (const char*)(A + (size_t)row0 * K); const char* gB = (const char*)(Bt + (size_t)pn * 256 * K);
    const size_t hstep = (size_t)128 * K * 2; const unsigned ldsw = (unsigned)wid * 1024u;
    const int aoff = pg8::lds_byte(fr, fq * 8), boff = pg8::lds_byte(wc * 32 + fr, fq * 8);
    constexpr int STG = 40960;
#define SK_STAGE(s, kt) do { const size_t ko_ = (size_t)(kt) * 128; \
        __builtin_amdgcn_global_load_lds((const unsigned*)(gA + voffA + ko_), (PG8_LAS unsigned*)(lds + (s) * STG + ldsw), 16, 0, 0); \
        _Pragma("unroll") for (int h_ = 0; h_ < 2; ++h_) _Pragma("unroll") for (int i_ = 0; i_ < 2; ++i_) \
            __builtin_amdgcn_global_load_lds((const unsigned*)(gB + h_ * hstep + voffB[i_] + ko_), (PG8_LAS unsigned*)(lds + (s) * STG + 8192 + h_ * 16384 + ldsw + i_ * 8192), 16, 0, 0); } while (0)
    f32x4 acc[2][2][4][2];
#pragma unroll
    for (int a = 0; a < 2; ++a)
#pragma unroll
        for (int b = 0; b < 2; ++b)
#pragma unroll
            for (int m = 0; m < 4; ++m)
#pragma unroll
                for (int n = 0; n < 2; ++n) acc[a][b][m][n] = (f32x4){0.f, 0.f, 0.f, 0.f};
    SK_STAGE(0, 0); SK_STAGE(1, 1);
    int s = 0;
    for (int kt = 0; kt < nt; ++kt) {
        if (kt + 1 < nt) asm volatile("s_waitcnt vmcnt(5)" ::: "memory"); else asm volatile("s_waitcnt vmcnt(0)" ::: "memory");
        __builtin_amdgcn_s_barrier(); asm volatile("" ::: "memory");
        if (kt + 2 < nt) { const int s2 = s >= 1 ? s - 1 : 2; SK_STAGE(s2, kt + 2); }
        if (wr == 0) {
            bf16x8 At[4][2], B0[2][2], B1[2][2];
#pragma unroll
            for (int m = 0; m < 4; ++m)
#pragma unroll
                for (int k = 0; k < 2; ++k) At[m][k] = *(const PG8_LAS bf16x8*)(lds + s * STG + aoff + m * 2048 + k * 1024);
#pragma unroll
            for (int n = 0; n < 2; ++n)
#pragma unroll
                for (int k = 0; k < 2; ++k) { B0[n][k] = *(const PG8_LAS bf16x8*)(lds + s * STG + 8192 + boff + n * 2048 + k * 1024); B1[n][k] = *(const PG8_LAS bf16x8*)(lds + s * STG + 8192 + 16384 + boff + n * 2048 + k * 1024); }
#pragma unroll
            for (int m = 0; m < 4; ++m)
#pragma unroll
                for (int n = 0; n < 2; ++n)
#pragma unroll
                    for (int k = 0; k < 2; ++k) { acc[0][0][m][n] = __builtin_amdgcn_mfma_f32_16x16x32_bf16(B0[n][k], At[m][k], acc[0][0][m][n], 0, 0, 0);
                                                  acc[0][1][m][n] = __builtin_amdgcn_mfma_f32_16x16x32_bf16(B1[n][k], At[m][k], acc[0][1][m][n], 0, 0, 0); }
        }
        s = s == 2 ? 0 : s + 1;
    }
#undef SK_STAGE
    asm volatile("s_waitcnt lgkmcnt(0)" ::: "memory"); __builtin_amdgcn_s_barrier(); asm volatile("" ::: "memory");
    E.template run<1>(acc, row0, pn, wr, wc, fr, fq, wr == 0);
}
__device__ __forceinline__ void skinny_map(int unit, int ncol, int& ps, int& pn) {
    const int x = unit & 7, r = unit >> 3, per = ncol / 8;
    ps = r & 7; pn = x * per + (r >> 3);
}

__device__ __forceinline__ void ph_gemm1_attn(const Args& a, unsigned char* shm, int bid, int nblk, int layer) {
    const int j = layer >> 1;
    pg8::Gemm g{(const bf16*)(a.ws + WS_XB), (const bf16*)(a.ws + WS_WIN) + (size_t)layer * NP * D, MP, NP, D};
    pg8::StaticOrder S; S.init(MP, NP, nblk, bid);
    EpiG1Attn E{(const float*)(a.ws + WS_SSQ), (bf16*)(a.ws + WS_QB), (bf16*)(a.ws + WS_KB), (bf16*)(a.ws + WS_VB), (bf16*)(a.ws + WS_GB), a.out, a.in[8] + j * HD, a.in[9] + j * HD, (float*)(shm + EPI_OFF), j};
    if (threadIdx.x == 0) *(volatile LAS int*)((LAS unsigned char*)shm + RS_TAG_OFF) = -1;
    __syncthreads();
    pg8::gemm_phase<EpiG1Attn, pg8::StaticOrder, true, true>((LAS unsigned char*)shm, g, S, E);
    for (int unit = bid; unit < (MS / 64) * (NP / 256); unit += nblk) { int ps, pn; skinny_map(unit, NP / 256, ps, pn); skinny_unit((LAS unsigned char*)shm, g.A, g.Bt, D, E, MP + 64 * ps, pn); }
}
__device__ __forceinline__ void ph_gemm1_hgrn(const Args& a, unsigned char* shm, int bid, int nblk, int layer) {
    const int j = layer >> 1;
    pg8::Gemm g{(const bf16*)(a.ws + WS_XB), (const bf16*)(a.ws + WS_WIN) + (size_t)layer * NP * D, MP, NP, D};
    pg8::StaticOrder S; S.init(MP, NP, nblk, bid);
    EpiG1Hgrn E{(const float*)(a.ws + WS_SSQ), (bf16*)(a.ws + WS_QB), (unsigned short*)(a.ws + WS_LF), (bf16*)(a.ws + WS_VB), (bf16*)(a.ws + WS_GB), (const float*)(a.ws + WS_OML) + j * D, (float*)(shm + EPI_OFF)};
    if (threadIdx.x == 0) *(volatile LAS int*)((LAS unsigned char*)shm + RS_TAG_OFF) = -1;
    __syncthreads();
    pg8::gemm_phase<EpiG1Hgrn, pg8::StaticOrder, true, true>((LAS unsigned char*)shm, g, S, E);
    for (int unit = bid; unit < (MS / 64) * (NP / 256); unit += nblk) { int ps, pn; skinny_map(unit, NP / 256, ps, pn); skinny_unit((LAS unsigned char*)shm, g.A, g.Bt, D, E, MP + 64 * ps, pn); }
}
template <bool BASE_F32, bool WRITE_Y> __device__ __forceinline__ void gemm2_run(const Args& a, unsigned char* shm, int bid, int nblk, int layer) {
    pg8::Gemm g{(const bf16*)(a.ws + WS_OG), (const bf16*)(a.ws + WS_WOUT) + (size_t)layer * D * D, MP, D, D};
    pg8::StaticOrder S; S.init(MP, D, nblk, bid);
    EpiG2<BASE_F32, WRITE_Y> E{a.in[0], a.in[1], a.out, (bf16*)(a.ws + WS_XB), (float*)(a.ws + WS_SSQ), (float*)(shm + EPI_OFF)};
    pg8::gemm_phase<EpiG2<BASE_F32, WRITE_Y>, pg8::StaticOrder, true, true>((LAS unsigned char*)shm, g, S, E);
    constexpr int NSK = (MS / 64) * (D / 256);
    for (int unit = bid; unit < NSK; unit += nblk) { int ps, pn; skinny_map(unit, D / 256, ps, pn); skinny_unit((LAS unsigned char*)shm, g.A, g.Bt, D, E, MP + 64 * ps, pn); }
}
__device__ __forceinline__ void ph_gemm2(const Args& a, unsigned char* shm, int bid, int nblk, int layer) {
    if (layer == DEPTH - 1) gemm2_run<false, true>(a, shm, bid, nblk, layer);
    else gemm2_run<false, false>(a, shm, bid, nblk, layer);
    if (layer + 1 < DEPTH) {
        constexpr int NSK = (MS / 64) * (D / 256);
        const int tid = fresh_tid(), lane = tid & 63, wave = tid >> 6; unsigned char* scr = shm + wave * (64 * 132);
        if (nblk > NSK) { if (bid >= NSK) convert_layer_weights(a, scr, layer + 1, (bid - NSK) * 8 + wave, (nblk - NSK) * 8, lane); }
        else convert_layer_weights(a, scr, layer + 1, bid * 8 + wave, nblk * 8, lane);
    }
}

constexpr int CW_BAR = 4096;
static_assert((CW_BAR + XCD_BAR_WORDS) * 4 <= (int)CTL_BYTES, "CTL region");

__global__ void __launch_bounds__(512, 2) mega_fwd(Args a) {
    extern __shared__ __attribute__((aligned(16))) unsigned char shm[];
    const int tid = threadIdx.x, bid = blockIdx.x, nblk = gridDim.x;
    for (int u = tid; u < 256; u += 512) ((LAS unsigned*)((LAS unsigned char*)shm + LDSCTL_OFF))[u] = 0u;
    __syncthreads();
    XcdBarrier bar = xcd_barrier_post((unsigned*)(a.ws + WS_CTL) + CW_BAR, (volatile LAS unsigned*)((LAS unsigned char*)shm + LDSCTL_OFF + 32));
    prologue_phase(a, shm, bid, nblk);
    xcd_barrier(bar);
#define LAYER_ATTN(L) do { ph_gemm1_attn(a, shm, bid, nblk, (L)); xcd_barrier(bar); ph_attn(a, shm, bid, nblk, (L)); xcd_barrier(bar); ph_gemm2(a, shm, bid, nblk, (L)); xcd_barrier(bar); } while (0)
#define LAYER_HGRN(L) do { ph_gemm1_hgrn(a, shm, bid, nblk, (L)); xcd_barrier(bar); ph_hgrn1(a, shm, bid, nblk, (L)); xcd_barrier(bar); ph_hgrn2(a, shm, bid, nblk, (L)); xcd_barrier(bar); ph_gemm2(a, shm, bid, nblk, (L)); xcd_barrier(bar); } while (0)
    LAYER_ATTN(0); LAYER_HGRN(1); LAYER_ATTN(2); LAYER_HGRN(3);
#undef LAYER_ATTN
#undef LAYER_HGRN
}

extern "C" void kernel_launch(void* const* d_in, const int* in_sizes, int n_in, void* d_out, int out_size, void* d_ws, size_t ws_size, hipStream_t stream) {
    static int grid = 0;
    if (grid == 0) {
        if (n_in != 12 || (size_t)out_size != O_END || ws_size < WS_END) { fprintf(stderr, "kernel_launch: unexpected shapes n_in %d out %d ws %zu\n", n_in, out_size, ws_size); grid = -1; return; }
        int dev = 0, cus = 0, per_cu = 0;
        if (hipGetDevice(&dev) != hipSuccess || hipDeviceGetAttribute(&cus, hipDeviceAttributeMultiprocessorCount, dev) != hipSuccess) { fprintf(stderr, "kernel_launch: device query failed\n"); grid = -1; return; }
        if (hipFuncSetAttribute((const void*)mega_fwd, hipFuncAttributeMaxDynamicSharedMemorySize, LDS_BYTES) != hipSuccess) { fprintf(stderr, "kernel_launch: hipFuncSetAttribute failed\n"); grid = -1; return; }
        if (hipOccupancyMaxActiveBlocksPerMultiprocessor(&per_cu, (const void*)mega_fwd, 512, LDS_BYTES) != hipSuccess || per_cu < 1) { fprintf(stderr, "kernel_launch: occupancy query says %d blocks per CU\n", per_cu); (void)hipGetLastError(); grid = -1; return; }
        grid = cus;
    }
    if (grid < 0) return;
    if (hipMemsetAsync((char*)d_ws + WS_CTL, 0, CTL_BYTES, stream) != hipSuccess) { fprintf(stderr, "kernel_launch: memset failed\n"); return; }
    Args a; memset(&a, 0, sizeof(a));
    for (int i = 0; i < 12; ++i) a.in[i] = (const float*)d_in[i];
    a.out = (float*)d_out; a.ws = (unsigned char*)d_ws;
    hipLaunchKernelGGL(mega_fwd, dim3(grid), dim3(512), LDS_BYTES, stream, a);
    const hipError_t le = hipPeekAtLastError();
    if (le != hipSuccess) fprintf(stderr, "kernel_launch: launch failed: %s\n", hipGetErrorName(le));
}
```

```cpp
#include <hip/hip_runtime.h>
#include <cstdio>
#include <cstdint>
#include <cstring>
__device__ __forceinline__ int fresh_tid() { int t = threadIdx.x; asm volatile("" : "+v"(t)); return t; }
namespace pg8 {
#define PG8_LAS __attribute__((address_space(3)))
typedef unsigned short bf16_t;
typedef short bf16x8 __attribute__((ext_vector_type(8)));
typedef float f32x4 __attribute__((ext_vector_type(4)));
typedef unsigned u32x4 __attribute__((ext_vector_type(4)));
constexpr int BM = 256, BK = 64, HALF = 128, HTB = HALF * BK * 2  , STAGE_BYTES = 8 * HTB, NXCD = 8, WGM = 4;

__host__ __device__ __forceinline__ int lds_byte(int r, int c) { const int st = (r >> 4) * 2 + (c >> 5), rr = r & 15, cc = c & 31, ob = rr * 64 + cc * 2; return st * 1024 + (ob ^ (((ob >> 9) & 1) << 5)); }
__host__ __device__ __forceinline__ void stage_rc(int b, int& R, int& C) { const int st = b / 1024, sb = b % 1024, swz = sb ^ (((sb >> 9) & 1) << 5); R = (st >> 1) * 16 + swz / 64; C = (st & 1) * 32 + (swz % 64) / 2; }
__host__ __device__ __forceinline__ int perm32(int rho) { const int n = rho >> 4, i = rho & 15; return 8 * (i >> 2) + 4 * n + (i & 3); }

struct Unit { int pm, pn; };
struct Gemm { const bf16_t* A; const bf16_t* Bt; int M, N, K; };

struct StaticOrder {
    int nM, nN, nwg, G, c;
    __host__ __device__ void init(int M, int N, int G_, int c_) { nM = M / BM; nN = N / BM; nwg = nM * nN; G = G_; c = c_; }
    __host__ __device__ bool next(int i, Unit& u) const {
        const long L = (long)i * G + c; if (L >= nwg) return false;
        int wgid = (int)L; { const int q = nwg / NXCD, r = nwg % NXCD, xcd = wgid % NXCD, off = wgid / NXCD; wgid = (xcd < r ? xcd * (q + 1) : r * (q + 1) + (xcd - r) * q) + off; }
        const int nig = WGM * nN, gid = wgid / nig, fm = gid * WGM, gsz = (nM - fm) < WGM ? (nM - fm) : WGM;
        u.pm = fm + ((wgid % nig) % gsz); u.pn = (wgid % nig) / gsz; return true;
    }
    __device__ __forceinline__ void a_ready(const Unit&) const {}
    __device__ __forceinline__ void done(const Unit&) const {}
};

__device__ __forceinline__ unsigned cvt_pk_bf16(float lo, float hi) { unsigned r; asm volatile("v_cvt_pk_bf16_f32 %0, %1, %2" : "=v"(r) : "v"(lo), "v"(hi)); return r; }
typedef float f32x2 __attribute__((ext_vector_type(2)));
template <class Epi, class Sched, bool ALIGN_EPI = false, bool SP2 = false>
__device__ __forceinline__ void gemm_phase(PG8_LAS unsigned char* lds, const Gemm g, const Sched& S, const Epi& E) {
    const int tid = fresh_tid(), wid = __builtin_amdgcn_readfirstlane(tid >> 6), lane = tid & 63, wr = wid >> 2, wc = wid & 3, fr = lane & 15, fq = lane >> 4;
    const int K = g.K, nt = K / BK;
    unsigned voffA[2], voffB[2];
#pragma unroll
    for (int i = 0; i < 2; ++i) { int R, C; stage_rc(tid * 16 + i * 8192, R, C); const int Rb = Epi::PERM ? ((R & ~31) + perm32(R & 31)) : R;
        voffA[i] = (unsigned)(R * K + C) * 2u; voffB[i] = (unsigned)(Rb * K + C) * 2u; }
    const size_t kstep = (size_t)(BK * 2);
    const size_t hstep = (size_t)HALF * K * 2;
    const size_t tstep = 2 * hstep;
    const unsigned ldsw = (unsigned)wid * 1024u;
    const int aoff = lds_byte(wr * 64 + fr, fq * 8), boff = lds_byte(wc * 32 + fr, fq * 8);
#define PG8_SA(b, h) (((b) * 2 + (h)) * HTB)
#define PG8_SB(b, h) ((4 + (b) * 2 + (h)) * HTB)
#define PG8_STAGE(bufoff, gbase, voff) do { _Pragma("unroll") for (int _i = 0; _i < 2; ++_i) \
        __builtin_amdgcn_global_load_lds((const unsigned*)((const char*)(gbase) + (voff)[_i]), (PG8_LAS unsigned*)(lds + (bufoff) + ldsw + _i * 8192), 16, 0, 0); } while (0)
#define PG8_LDA(dst, b, h) do { _Pragma("unroll") for (int m = 0; m < 4; ++m) _Pragma("unroll") for (int k = 0; k < 2; ++k) dst[m][k] = *(const PG8_LAS bf16x8*)(lds + PG8_SA(b, h) + aoff + m * 2048 + k * 1024); } while (0)
#define PG8_LDB(dst, b, h) do { _Pragma("unroll") for (int n = 0; n < 2; ++n) _Pragma("unroll") for (int k = 0; k < 2; ++k) dst[n][k] = *(const PG8_LAS bf16x8*)(lds + PG8_SB(b, h) + boff + n * 2048 + k * 1024); } while (0)
#define PG8_MMA(ai, bj, At, Bt) do { __builtin_amdgcn_s_setprio(1); _Pragma("unroll") for (int m = 0; m < 4; ++m) _Pragma("unroll") for (int n = 0; n < 2; ++n) _Pragma("unroll") for (int k = 0; k < 2; ++k) \
        acc[ai][bj][m][n] = __builtin_amdgcn_mfma_f32_16x16x32_bf16(Bt[n][k], At[m][k], acc[ai][bj][m][n], 0, 0, 0); __builtin_amdgcn_s_setprio(0); } while (0)
#define PG8_WAIT_V(n) asm volatile("s_waitcnt vmcnt(" #n ")" ::: "memory")
#define PG8_WAIT_L(n) asm volatile("s_waitcnt lgkmcnt(" #n ")" ::: "memory")
#define PG8_BAR __builtin_amdgcn_s_barrier()
#define PG8_SCHED __builtin_amdgcn_sched_barrier(0)
    Unit cur, nxt; int ui = 0;
    if (!S.next(0, cur)) return;
    f32x4 acc[2][2][4][2];
#pragma unroll
    for (int a = 0; a < 2; ++a)
#pragma unroll
        for (int b = 0; b < 2; ++b)
#pragma unroll
            for (int m = 0; m < 4; ++m)
#pragma unroll
                for (int n = 0; n < 2; ++n) acc[a][b][m][n] = (f32x4){0.f, 0.f, 0.f, 0.f};
    bf16x8 At[4][2], B0[2][2], B1[2][2];
    const char* cA = (const char*)g.A + (size_t)cur.pm * tstep; const char* cB = (const char*)g.Bt + (size_t)cur.pn * tstep;
    S.a_ready(cur);
    if constexpr (SP2) {
        PG8_STAGE(PG8_SB(0, 0), cB, voffB); PG8_STAGE(PG8_SB(0, 1), cB + hstep, voffB); PG8_STAGE(PG8_SA(0, 0), cA, voffA); PG8_STAGE(PG8_SA(0, 1), cA + hstep, voffA);
        if (wr == 1) PG8_BAR;
        PG8_WAIT_V(2); PG8_BAR;
        PG8_STAGE(PG8_SB(1, 0), cB + kstep, voffB); PG8_STAGE(PG8_SA(1, 0), cA + kstep, voffA); PG8_STAGE(PG8_SB(1, 1), cB + hstep + kstep, voffB);
        PG8_WAIT_V(6); PG8_BAR;
    } else {
        PG8_STAGE(PG8_SB(0, 0), cB, voffB); PG8_STAGE(PG8_SA(0, 0), cA, voffA); PG8_STAGE(PG8_SB(0, 1), cB + hstep, voffB); PG8_STAGE(PG8_SA(0, 1), cA + hstep, voffA);
        if (wr == 1) PG8_BAR;
        PG8_WAIT_V(4); PG8_BAR;
        PG8_STAGE(PG8_SB(1, 0), cB + kstep, voffB); PG8_STAGE(PG8_SA(1, 0), cA + kstep, voffA); PG8_STAGE(PG8_SB(1, 1), cB + hstep + kstep, voffB);
        PG8_WAIT_V(6); PG8_BAR;
    }
    for (;;) {
        const bool has_next = S.next(ui + 1, nxt);
        const char* nA = has_next ? (const char*)g.A + (size_t)nxt.pm * tstep : cA; const char* nB = has_next ? (const char*)g.Bt + (size_t)nxt.pn * tstep : cB;
        asm volatile(".p2align 8" ::: "memory");
        for (int t = 0; t < nt; t += 2) {
            const bool last = (t == nt - 2);
            const char* a1 = cA + (size_t)(t + 1) * kstep;
            const char* a2 = last ? nA : cA + (size_t)(t + 2) * kstep; const char* b2 = last ? nB : cB + (size_t)(t + 2) * kstep;
            const char* a3 = a2 + kstep; const char* b3 = b2 + kstep;
            if (last && has_next) S.a_ready(nxt);
            if constexpr (SP2) {
            PG8_LDB(B0, 0, 0); PG8_LDB(B1, 0, 1); PG8_SCHED; PG8_LDA(At, 0, 0); PG8_STAGE(PG8_SA(1, 1), a1 + hstep, voffA);
            PG8_WAIT_V(8); PG8_WAIT_L(0); PG8_BAR; PG8_MMA(0, 0, At, B0); PG8_MMA(0, 1, At, B1); PG8_BAR; PG8_SCHED;
            PG8_LDA(At, 0, 1); PG8_STAGE(PG8_SB(0, 0), b2, voffB); PG8_STAGE(PG8_SB(0, 1), b2 + hstep, voffB); PG8_STAGE(PG8_SA(0, 0), a2, voffA);
            PG8_WAIT_V(8); PG8_WAIT_L(0); PG8_BAR; PG8_MMA(1, 0, At, B0); PG8_MMA(1, 1, At, B1); PG8_BAR; PG8_SCHED;
            PG8_LDB(B0, 1, 0); PG8_LDB(B1, 1, 1); PG8_SCHED; PG8_LDA(At, 1, 0); PG8_STAGE(PG8_SA(0, 1), a2 + hstep, voffA);
            PG8_WAIT_V(8); PG8_WAIT_L(0); PG8_BAR; PG8_MMA(0, 0, At, B0); PG8_MMA(0, 1, At, B1); PG8_BAR; PG8_SCHED;
            PG8_LDA(At, 1, 1); PG8_STAGE(PG8_SB(1, 0), b3, voffB); PG8_STAGE(PG8_SB(1, 1), b3 + hstep, voffB); PG8_STAGE(PG8_SA(1, 0), a3, voffA);
            PG8_WAIT_V(8); PG8_WAIT_L(0); PG8_BAR; PG8_MMA(1, 0, At, B0); PG8_MMA(1, 1, At, B1); PG8_BAR; PG8_SCHED;
            } else {
            PG8_LDB(B0, 0, 0); PG8_SCHED; PG8_LDA(At, 0, 0); PG8_STAGE(PG8_SA(1, 1), a1 + hstep, voffA);
            PG8_WAIT_L(8); PG8_BAR; PG8_WAIT_L(0); PG8_MMA(0, 0, At, B0); PG8_BAR; PG8_SCHED;
            PG8_LDB(B1, 0, 1); PG8_STAGE(PG8_SB(0, 0), b2, voffB);
            PG8_BAR; PG8_WAIT_L(0); PG8_MMA(0, 1, At, B1); PG8_BAR;
            PG8_LDA(At, 0, 1); PG8_STAGE(PG8_SA(0, 0), a2, voffA);
            PG8_BAR; PG8_WAIT_L(0); PG8_MMA(1, 0, At, B0); PG8_BAR; PG8_SCHED;
            PG8_STAGE(PG8_SB(0, 1), b2 + hstep, voffB);
            PG8_WAIT_V(6); PG8_BAR; PG8_MMA(1, 1, At, B1); PG8_BAR;
            PG8_LDB(B0, 1, 0); PG8_SCHED; PG8_LDA(At, 1, 0); PG8_STAGE(PG8_SA(0, 1), a2 + hstep, voffA);
            PG8_WAIT_L(8); PG8_BAR; PG8_WAIT_L(0); PG8_MMA(0, 0, At, B0); PG8_BAR; PG8_SCHED;
            PG8_LDB(B1, 1, 1); PG8_STAGE(PG8_SB(1, 0), b3, voffB);
            PG8_BAR; PG8_WAIT_L(0); PG8_MMA(0, 1, At, B1); PG8_BAR;
            PG8_LDA(At, 1, 1); PG8_STAGE(PG8_SA(1, 0), a3, voffA);
            PG8_BAR; PG8_WAIT_L(0); PG8_MMA(1, 0, At, B0); PG8_BAR; PG8_SCHED;
            PG8_STAGE(PG8_SB(1, 1), b3 + hstep, voffB);
            PG8_WAIT_V(6); PG8_BAR; PG8_MMA(1, 1, At, B1); PG8_BAR;
            }
        }
        if constexpr (ALIGN_EPI) { if (wr == 0) PG8_BAR; }
        if constexpr (!Epi::AFTER_DRAIN) { E(acc, cur, wr, wc, fr, fq); S.done(cur); }
        if (!has_next) break;
#pragma unroll
        for (int a = 0; a < 2; ++a)
#pragma unroll
            for (int b = 0; b < 2; ++b)
#pragma unroll
                for (int m = 0; m < 4; ++m)
#pragma unroll
                    for (int n = 0; n < 2; ++n) acc[a][b][m][n] = (f32x4){0.f, 0.f, 0.f, 0.f};
        cur = nxt; cA = nA; cB = nB; ++ui;
        if constexpr (ALIGN_EPI) { if (wr == 1) PG8_BAR; }
    }
    PG8_WAIT_V(0);
    if constexpr (!ALIGN_EPI) { if (wr == 0) PG8_BAR; }
    PG8_BAR;
    if constexpr (Epi::AFTER_DRAIN) { E.fused(acc, cur, wr, wc, fr, fq, lds, wid, lane); S.done(cur); }
#undef PG8_SA
#undef PG8_SB
#undef PG8_STAGE
#undef PG8_LDA
#undef PG8_LDB
#undef PG8_MMA
#undef PG8_WAIT_V
#undef PG8_WAIT_L
#undef PG8_BAR
#undef PG8_SCHED
}
}

constexpr int D = 2048, NH = 16, HD = 128, NP = 8192, DEPTH = 4;
constexpr int BP = 4, TP = 4096, MP = BP * TP;
constexpr int BS = 16, TS = 32, MS = BS * TS, PAST = 2048;
constexpr int M = MP + MS;
constexpr float EPS = 1e-6f;
constexpr float LOG2E = 1.4426950408889634f;
constexpr float QSCALE = 0.08838834764831845f * LOG2E;
constexpr float SB_EXIT_LIN = 1e-24f;
constexpr size_t O_YP = 0, O_YS = O_YP + (size_t)MP * D, O_KP = O_YS + (size_t)MS * D, O_VP = O_KP + 2 * (size_t)MP * D, O_SP = O_VP + 2 * (size_t)MP * D,
                 O_KS = O_SP + 2 * (size_t)BP * NH * HD * HD, O_VS = O_KS + 2 * (size_t)MS * D, O_SS = O_VS + 2 * (size_t)MS * D, O_END = O_SS + 2 * (size_t)BS * NH * HD * HD;
static_assert(O_END == 183500800ull, "output size");
constexpr size_t MiB = 1u << 20;
constexpr size_t WS_CTL = 0, CTL_BYTES = 1 * MiB;
constexpr size_t WS_WIN = 1 * MiB;
constexpr size_t WS_WOUT = 129 * MiB;
constexpr size_t WS_XB = 161 * MiB;
constexpr size_t WS_SSQ = 227 * MiB;
constexpr size_t WS_OML = WS_SSQ + 768 * 1024;
constexpr size_t WS_QB = 228 * MiB, WS_KB = 294 * MiB, WS_VB = 360 * MiB, WS_GB = 426 * MiB;
constexpr size_t WS_LF = 492 * MiB;
constexpr size_t WS_OG = 624 * MiB;
constexpr size_t WS_HL = 690 * MiB;
constexpr size_t WS_END = 706 * MiB;

#define LAS __attribute__((address_space(3)))
typedef unsigned short bf16;
typedef float f32x4 __attribute__((ext_vector_type(4)));
typedef float f32x2 __attribute__((ext_vector_type(2)));
typedef unsigned u32x4 __attribute__((ext_vector_type(4)));
typedef unsigned u32x2 __attribute__((ext_vector_type(2)));
__device__ __forceinline__ float bf2f(unsigned short b) { return __uint_as_float(((unsigned)b) << 16); }
__device__ __forceinline__ float bflo(unsigned w) { return __uint_as_float(w << 16); }
__device__ __forceinline__ float bfhi(unsigned w) { return __uint_as_float(w & 0xffff0000u); }
__device__ __forceinline__ unsigned f2bf(float f) { unsigned u = __float_as_uint(f); return (u + 0x7fffu + ((u >> 16) & 1u)) >> 16; }
__device__ __forceinline__ unsigned pk2(float lo, float hi) { return f2bf(lo) | (f2bf(hi) << 16); }
__device__ __forceinline__ float wave_sum(float v) {
#pragma unroll
    for (int o = 1; o < 64; o <<= 1) v += __shfl_xor(v, o);
    return v;
}
__device__ __forceinline__ float silu_f(float x) { return x * __builtin_amdgcn_rcpf(1.0f + __expf(-x)); }

#define WG_BAR() do { asm volatile("s_waitcnt lgkmcnt(0)" ::: "memory"); __builtin_amdgcn_s_barrier(); asm volatile("" ::: "memory"); } while (0)
__device__ __forceinline__ size_t hm(int row, int h) { return ((size_t)h * M + row) * HD; }
struct Args { const float* in[12]; float* out; unsigned char* ws; };

__device__ __forceinline__ float row_rstd(const float* ssq, int row) {
    const f32x4 a = *(const f32x4*)(ssq + (size_t)row * 8), b = *(const f32x4*)(ssq + (size_t)row * 8 + 4);
    const float s = ((a.x + a.y) + (a.z + a.w)) + ((b.x + b.y) + (b.z + b.w));
    return rsqrtf(s * (1.0f / D) + EPS);
}
__device__ __forceinline__ float hgrn_lower_bound(const float* hgrn_lb, int j, int c) {
    if (j == 0) return 0.0f;
    const float l0 = hgrn_lb[c], l1 = hgrn_lb[D + c], mx = fmaxf(l0, l1), e0 = __expf(l0 - mx), e1 = __expf(l1 - mx);
    return fminf(fmaxf(e1 / (e0 + e1), 0.0f), 1.0f - 1e-6f);
}

constexpr int RING_BYTES = 131072;
constexpr int LDSCTL_OFF = RING_BYTES;
constexpr int EPI_OFF = LDSCTL_OFF + 1024;
constexpr int LDS_BYTES = 147456;
static_assert(EPI_OFF + 8192 <= LDS_BYTES, "LDS map");
#define XB_TMO      128
#define XB_XCNT(j)  (256  + 64 * (j))
#define XB_XSUB(j)  (1280 + 64 * (j))
#define XB_XGEN(j)  (2304 + 64 * (j))
#define XB_TOP      3328
#define XB_TOPGEN   3392
#define XCD_BAR_WORDS 3456
#define XB_SPIN_CAP (1u << 18)

__device__ __forceinline__ unsigned xb_ld(unsigned* p)              { return __hip_atomic_load(p, __ATOMIC_RELAXED, __HIP_MEMORY_SCOPE_AGENT); }
__device__ __forceinline__ unsigned xb_add(unsigned* p, unsigned v) { return __hip_atomic_fetch_add(p, v, __ATOMIC_RELAXED, __HIP_MEMORY_SCOPE_AGENT); }
__device__ __forceinline__ unsigned xb_xcc_id() { return (unsigned)__builtin_amdgcn_s_getreg((3 << 11) | 20) & 0xFu; }
#define XB_SPIN(cond, bar) do { unsigned _sp = 0; while (cond) { __builtin_amdgcn_s_sleep(1); \
    if ((++_sp & 255u) == 0u) { if (xb_ld(&(bar)[XB_TMO])) break; if (_sp > XB_SPIN_CAP) { atomicAdd(&(bar)[XB_TMO], 1u); break; } } } } while (0)

struct XcdBarrier {
    unsigned* bar; unsigned x;
    volatile LAS unsigned* st;
};

__device__ __forceinline__ XcdBarrier xcd_barrier_post(unsigned* bar, volatile LAS unsigned* st) {
    XcdBarrier b; b.bar = bar; b.x = xb_xcc_id(); b.st = st;
    if (threadIdx.x == 0) (void)xb_add(&bar[XB_XCNT(b.x)], 1u);
    return b;
}
__device__ __forceinline__ void xcd_barrier_complete(unsigned* bar, unsigned x, unsigned& nloc, unsigned& nx) {
    const unsigned G = gridDim.x * gridDim.y * gridDim.z;
    unsigned sum, cnt, mine, sp = 0u;
    for (;;) {
        sum = 0u; cnt = 0u; mine = 0u;
#pragma unroll
        for (unsigned j = 0; j < 16; ++j) { const unsigned c = xb_ld(&bar[XB_XCNT(j)]); sum += c; cnt += (c > 0u) ? 1u : 0u; mine = (j == x) ? c : mine; }
        if (sum == G) break;
        __builtin_amdgcn_s_sleep(1);
        if ((++sp & 255u) == 0u) { if (xb_ld(&bar[XB_TMO])) break; if (sp > XB_SPIN_CAP) { atomicAdd(&bar[XB_TMO], 1u); break; } }
    }
    nloc = mine > 0u ? mine : 1u; nx = cnt > 0u ? cnt : 1u;
}

__device__ __forceinline__ void xcd_barrier(const XcdBarrier& b) {
    asm volatile("s_waitcnt vmcnt(0)" ::: "memory");
    __syncthreads();
    if (threadIdx.x == 0) {
        unsigned* bar = b.bar;
        __builtin_amdgcn_s_waitcnt(0);
        unsigned nloc = b.st[0], nx = b.st[1];
        if (nloc == 0u) { xcd_barrier_complete(bar, b.x, nloc, nx); b.st[0] = nloc; b.st[1] = nx; }
        const unsigned old = xb_add(&bar[XB_XSUB(b.x)], 1u);
        const unsigned gen = old / nloc;
        if (old + 1u == (gen + 1u) * nloc) {
            __builtin_amdgcn_fence(__ATOMIC_RELEASE, "agent");
            asm volatile("s_waitcnt vmcnt(0)" ::: "memory");
            const unsigned og = xb_add(&bar[XB_TOP], 1u);
            const unsigned tg = og / nx;
            if (og + 1u == (tg + 1u) * nx) xb_add(&bar[XB_TOPGEN], 1u);
            else XB_SPIN(xb_ld(&bar[XB_TOPGEN]) == tg, bar);
            __builtin_amdgcn_fence(__ATOMIC_ACQUIRE, "agent");
            xb_add(&bar[XB_XGEN(b.x)], 1u);
            asm volatile("s_waitcnt vmcnt(0)" ::: "memory");
        } else {
            XB_SPIN(xb_ld(&bar[XB_XGEN(b.x)]) == gen, bar);
            __builtin_amdgcn_fence(__ATOMIC_ACQUIRE, "agent");
            asm volatile("s_waitcnt vmcnt(0)" ::: "memory");
        }
    }
    __syncthreads();
}
__device__ __forceinline__ void transpose_item(const float* W, const float* kscale, int K, int N, bf16* WT, unsigned char* scr, int item, int lane) {
    const int nblk = N / 64, kb = item / nblk, nb = item % nblk, k0 = 64 * kb, n0 = 64 * nb, ks = lane >> 4, n4 = (lane & 15) * 4;
    f32x4 v[16];
#pragma unroll
    for (int i = 0; i < 8; ++i) { const float* src = W + (size_t)(k0 + 8 * i + 2 * ks) * N + n0 + n4; v[2 * i] = *(const f32x4*)src; v[2 * i + 1] = *(const f32x4*)(src + N); }
    f32x2 sc[8];
#pragma unroll
    for (int i = 0; i < 8; ++i) { if (kscale) sc[i] = *(const f32x2*)(kscale + k0 + 8 * i + 2 * ks); else sc[i] = (f32x2){1.f, 1.f}; }
#pragma unroll
    for (int i = 0; i < 8; ++i)
#pragma unroll
        for (int e = 0; e < 4; ++e) *(unsigned*)(scr + (n4 + e) * 132 + 16 * i + 4 * ks) = pg8::cvt_pk_bf16(v[2 * i][e] * sc[i].x, v[2 * i + 1][e] * sc[i].y);
    __builtin_amdgcn_s_waitcnt(0xc07f); asm volatile("" ::: "memory");
    const int c = lane & 7;
#pragma unroll
    for (int ps = 0; ps < 8; ++ps) { const int n = (lane >> 3) + 8 * ps; const unsigned char* s = scr + n * 132 + 16 * c;
        u32x4 o; o.x = *(const unsigned*)s; o.y = *(const unsigned*)(s + 4); o.z = *(const unsigned*)(s + 8); o.w = *(const unsigned*)(s + 12);
        *(u32x4*)(WT + (size_t)(n0 + n) * K + k0 + 8 * c) = o; }
    __builtin_amdgcn_s_waitcnt(0xc07f); asm volatile("" ::: "memory");
}
__device__ __forceinline__ void convert_layer_weights(const Args& a, unsigned char* scr, int l, int gw, int ngw, int lane) {
    const float* norm_w = a.in[5]; const float* w_in = a.in[6]; const float* w_out = a.in[7];
    bf16* WinT = (bf16*)(a.ws + WS_WIN); bf16* WoutT = (bf16*)(a.ws + WS_WOUT);
    constexpr int I_IN = (D / 64) * (NP / 64), I_OUT = (D / 64) * (D / 64);
    for (int r = gw; r < I_IN + I_OUT; r += ngw) {
        if (r < I_IN) transpose_item(w_in + (size_t)l * D * NP, norm_w + l * D, D, NP, WinT + (size_t)l * NP * D, scr, r, lane);
        else transpose_item(w_out + (size_t)l * D * D, nullptr, D, D, WoutT + (size_t)l * D * D, scr, r - I_IN, lane);
    }
}
__device__ __forceinline__ void prologue_phase(const Args& a, unsigned char* shm, int bid, int nblk) {
    const int tid = fresh_tid(), lane = tid & 63, wave = tid >> 6;
    unsigned char* scr = shm + wave * (64 * 132);
    const int gw = bid * 8 + wave, NGW = nblk * 8;
    convert_layer_weights(a, scr, 0, gw, NGW, lane);
    if (bid == 0) { float* oml = (float*)(a.ws + WS_OML); for (int c = tid; c < 2 * D; c += 512) oml[c] = 1.0f - hgrn_lower_bound(a.in[11], c / D, c % D); }
    bf16* XB = (bf16*)(a.ws + WS_XB); float* ssq = (float*)(a.ws + WS_SSQ);
    for (int row = gw; row < M; row += NGW) {
        const float* src = row < MP ? a.in[0] + (size_t)row * D : a.in[1] + (size_t)(row - MP) * D;
        float s = 0.f;
#pragma unroll
        for (int j = 0; j < 8; ++j) { const f32x4 v = *(const f32x4*)(src + 4 * (lane + 64 * j)); s += (v.x * v.x + v.y * v.y) + (v.z * v.z + v.w * v.w);
            u32x2 o; o.x = pg8::cvt_pk_bf16(v.x, v.y); o.y = pg8::cvt_pk_bf16(v.z, v.w); *(u32x2*)(XB + (size_t)row * D + 4 * (lane + 64 * j)) = o; }
        s = wave_sum(s);
        if (lane < 8) ssq[(size_t)row * 8 + lane] = lane == 0 ? s : 0.f;
    }
}


namespace att {
using bf16x8 = __attribute__((ext_vector_type(8))) short;
using s16x4  = __attribute__((ext_vector_type(4))) short;
using f32x16 = __attribute__((ext_vector_type(16))) float;
constexpr int SHM_T = 64 * 128 * 2;
#define ATT_KSWZ(row, colB) ((row) * 256 + ((colB) ^ (((row) & 7) << 4)))
__device__ __forceinline__ int crow(int r, int hi) { return (r & 3) + 8 * (r >> 2) + 4 * hi; }
__device__ __forceinline__ unsigned cvtpk(float lo, float hi) { unsigned r; asm volatile("v_cvt_pk_bf16_f32 %0, %1, %2" : "=v"(r) : "v"(lo), "v"(hi)); return r; }
__device__ __forceinline__ int v_st(int k, int c) { const int kk = (k & ~0xC) | ((k & 4) << 1) | ((k & 8) >> 1); return ((kk >> 3) * 4 + (c >> 5)) * 512 + ((kk & 7) * 32 + (c & 31)) * 2; }
__device__ __forceinline__ int v_rd_base(int lane) { return ((lane & 3) << 3) | (((lane >> 2) & 3) << 6) | (((lane >> 4) & 1) << 5) | (((lane >> 5) & 1) << 8); }
constexpr int v_rd_off(int d0, int ks, int half) { return d0 * 512 + ks * 4096 + half * 2048; }
template <int OFF> __device__ __forceinline__ s16x4 tr_read(int vb) { s16x4 r; asm volatile("ds_read_b64_tr_b16 %0, %1 offset:%2" : "=&v"(r) : "v"(vb), "i"(OFF) : "memory"); return r; }
__device__ __forceinline__ void qkt(f32x16& p0, f32x16& p1, const char* Ks, const bf16x8* qr, int r32, int hi) {
    p0 = f32x16{}; p1 = f32x16{};
#pragma unroll
    for (int d0 = 0; d0 < 8; ++d0) { const int cb = (d0 * 16 + hi * 8) * 2;
        const bf16x8 b0 = *reinterpret_cast<const bf16x8*>(Ks + ATT_KSWZ(r32, cb));
        const bf16x8 b1 = *reinterpret_cast<const bf16x8*>(Ks + ATT_KSWZ(32 + r32, cb));
        p0 = __builtin_amdgcn_mfma_f32_32x32x16_bf16(b0, qr[d0], p0, 0, 0, 0);
        p1 = __builtin_amdgcn_mfma_f32_32x32x16_bf16(b1, qr[d0], p1, 0, 0, 0); }
}
template <int D0> __device__ __forceinline__ void pv_one(f32x16& od, int vb, bf16x8 pa0, bf16x8 pa1, bf16x8 pa2, bf16x8 pa3) {
    const s16x4 l0 = tr_read<v_rd_off(D0, 0, 0)>(vb), h0 = tr_read<v_rd_off(D0, 0, 1)>(vb), l1 = tr_read<v_rd_off(D0, 1, 0)>(vb), h1 = tr_read<v_rd_off(D0, 1, 1)>(vb);
    const s16x4 l2 = tr_read<v_rd_off(D0, 2, 0)>(vb), h2 = tr_read<v_rd_off(D0, 2, 1)>(vb), l3 = tr_read<v_rd_off(D0, 3, 0)>(vb), h3 = tr_read<v_rd_off(D0, 3, 1)>(vb);
    asm volatile("s_waitcnt lgkmcnt(0)" ::: "memory"); __builtin_amdgcn_sched_barrier(0);
#define ATT_PK(L, H) (bf16x8){L[0], L[1], L[2], L[3], H[0], H[1], H[2], H[3]}
    od = __builtin_amdgcn_mfma_f32_32x32x16_bf16(ATT_PK(l0, h0), pa0, od, 0, 0, 0);
    od = __builtin_amdgcn_mfma_f32_32x32x16_bf16(ATT_PK(l1, h1), pa1, od, 0, 0, 0);
    od = __builtin_amdgcn_mfma_f32_32x32x16_bf16(ATT_PK(l2, h2), pa2, od, 0, 0, 0);
    od = __builtin_amdgcn_mfma_f32_32x32x16_bf16(ATT_PK(l3, h3), pa3, od, 0, 0, 0);
#undef ATT_PK
}
template <bool CHECK_NEG, bool MASK> __device__ __forceinline__ float sb_half(f32x16& p, float C, int kpos0, int qpos, int hi) {
    float om[16];
#pragma unroll
    for (int r = 0; r < 16; ++r) { const float e = __builtin_amdgcn_exp2f(fminf(p[r], 80.f)), q = __builtin_amdgcn_rcpf(1.0f + e); float be = e * q, o1 = q;
        if (MASK) { const int pos = kpos0 + crow(r, hi); const bool valid = (pos < qpos) && (!CHECK_NEG || pos >= 0); be = valid ? be : 0.f; o1 = valid ? o1 : 1.f; }
        p[r] = be; om[r] = o1; }
    float s[4], ex[4];
#pragma unroll
    for (int g = 0; g < 4; ++g) {
        const float o0 = om[4 * g], o1 = om[4 * g + 1], o2 = om[4 * g + 2], o3 = om[4 * g + 3];
        const float e2 = o3, e1 = e2 * o2, e0 = e1 * o1, tt = e0 * o0;
        om[4 * g + 3] = 1.f; om[4 * g + 2] = e2; om[4 * g + 1] = e1; om[4 * g] = e0;
        const auto rr = __builtin_amdgcn_permlane32_swap(__float_as_uint(tt), __float_as_uint(tt), false, false);
        s[g] = __uint_as_float(rr[0]) * __uint_as_float(rr[1]); ex[g] = hi ? 1.f : __uint_as_float(rr[1]); }
    float base[4];
    base[3] = C; base[2] = base[3] * s[3]; base[1] = base[2] * s[2]; base[0] = base[1] * s[1];
    const float Cn = base[0] * s[0];
#pragma unroll
    for (int g = 0; g < 4; ++g) { const float bg = base[g] * ex[g];
        p[4 * g + 3] *= bg; p[4 * g + 2] *= om[4 * g + 2] * bg; p[4 * g + 1] *= om[4 * g + 1] * bg; p[4 * g] *= om[4 * g] * bg; }
    return Cn;
}
#define ATT_PK4(P, BASE, OUT) do { const unsigned a0_ = cvtpk(P[BASE + 0], P[BASE + 1]), a1_ = cvtpk(P[BASE + 2], P[BASE + 3]); \
    const unsigned b0_ = cvtpk(P[BASE + 4], P[BASE + 5]), b1_ = cvtpk(P[BASE + 6], P[BASE + 7]); \
    const auto r0_ = __builtin_amdgcn_permlane32_swap(a0_, b0_, false, false); const auto r1_ = __builtin_amdgcn_permlane32_swap(a1_, b1_, false, false); \
    u32x4 w_ = {r0_[0], r1_[0], r0_[1], r1_[1]}; OUT = *reinterpret_cast<bf16x8*>(&w_); } while (0)

struct Stg { bf16x8 k0, k1, v0, v1; };
__device__ __forceinline__ bf16x8 cvt8(const float* p) { const f32x4 x = *(const f32x4*)p, y = *(const f32x4*)(p + 4); u32x4 w = {cvtpk(x.x, x.y), cvtpk(x.z, x.w), cvtpk(y.x, y.y), cvtpk(y.z, y.w)}; return *reinterpret_cast<bf16x8*>(&w); }
template <bool SAMPLE> __device__ __forceinline__ void load_kv(const Args& a, int j, int b, int h, int pb, int sr, int sc, Stg& st) {
    const bf16* KB = (const bf16*)(a.ws + WS_KB); const bf16* VB = (const bf16*)(a.ws + WS_VB);
    if constexpr (!SAMPLE) {
        const size_t o0 = hm(b * TP + pb + sr, h) + sc, o1 = o0 + (size_t)32 * HD;
        st.k0 = *(const bf16x8*)(KB + o0); st.k1 = *(const bf16x8*)(KB + o1); st.v0 = *(const bf16x8*)(VB + o0); st.v1 = *(const bf16x8*)(VB + o1);
    } else {
        const float* ck = a.in[2] + ((size_t)(j * BS + b) * PAST) * D + h * HD + sc; const float* cv = a.in[3] + ((size_t)(j * BS + b) * PAST) * D + h * HD + sc;
        const bf16x8 zero = {0, 0, 0, 0, 0, 0, 0, 0};
        const int p0 = pb + sr, p1 = pb + 32 + sr;
        if (p0 >= PAST) { const size_t o = hm(MP + b * TS + (p0 - PAST), h) + sc; st.k0 = *(const bf16x8*)(KB + o); st.v0 = *(const bf16x8*)(VB + o); }
        else if (p0 >= 0) { st.k0 = cvt8(ck + (size_t)p0 * D); st.v0 = cvt8(cv + (size_t)p0 * D); }
        else { st.k0 = zero; st.v0 = zero; }
        if (p1 >= PAST) { const size_t o = hm(MP + b * TS + (p1 - PAST), h) + sc; st.k1 = *(const bf16x8*)(KB + o); st.v1 = *(const bf16x8*)(VB + o); }
        else if (p1 >= 0) { st.k1 = cvt8(ck + (size_t)p1 * D); st.v1 = cvt8(cv + (size_t)p1 * D); }
        else { st.k1 = zero; st.v1 = zero; }
    }
}
__device__ __forceinline__ void write_kv(char* V_lds, char* K_lds, int buf, int sr, int sc, const Stg& st) {
    *(bf16x8*)(V_lds + buf * SHM_T + v_st(sr, sc)) = st.v0; *(bf16x8*)(V_lds + buf * SHM_T + v_st(32 + sr, sc)) = st.v1;
    *(bf16x8*)(K_lds + buf * SHM_T + ATT_KSWZ(sr, sc * 2)) = st.k0; *(bf16x8*)(K_lds + buf * SHM_T + ATT_KSWZ(32 + sr, sc * 2)) = st.k1;
}
struct StgF { f32x4 k0a, k0b, v0a, v0b, k1a, k1b, v1a, v1b; };
__device__ __forceinline__ void load_cache(const Args& a, int j, int b, int h, int pb, int sr, int sc, StgF& s) {
    const size_t base = ((size_t)(j * BS + b) * PAST) * D + h * HD + sc; const float* ck = a.in[2] + base; const float* cv = a.in[3] + base;
    const size_t o0 = (size_t)max(pb + sr, 0) * D, o1 = (size_t)(pb + 32 + sr) * D;
    s.k0a = *(const f32x4*)(ck + o0); s.k0b = *(const f32x4*)(ck + o0 + 4); s.v0a = *(const f32x4*)(cv + o0); s.v0b = *(const f32x4*)(cv + o0 + 4);
    s.k1a = *(const f32x4*)(ck + o1); s.k1b = *(const f32x4*)(ck + o1 + 4); s.v1a = *(const f32x4*)(cv + o1); s.v1b = *(const f32x4*)(cv + o1 + 4);
}
__device__ __forceinline__ bf16x8 cvt8r(const f32x4 x, const f32x4 y) { u32x4 w = {cvtpk(x.x, x.y), cvtpk(x.z, x.w), cvtpk(y.x, y.y), cvtpk(y.z, y.w)}; return *reinterpret_cast<bf16x8*>(&w); }
__device__ __forceinline__ void write_kvf(char* V_lds, char* K_lds, int buf, int sr, int sc, const StgF& s) {
    *(bf16x8*)(V_lds + buf * SHM_T + v_st(sr, sc)) = cvt8r(s.v0a, s.v0b); *(bf16x8*)(V_lds + buf * SHM_T + v_st(32 + sr, sc)) = cvt8r(s.v1a, s.v1b);
    *(bf16x8*)(K_lds + buf * SHM_T + ATT_KSWZ(sr, sc * 2)) = cvt8r(s.k0a, s.k0b); *(bf16x8*)(K_lds + buf * SHM_T + ATT_KSWZ(32 + sr, sc * 2)) = cvt8r(s.k1a, s.k1b);
}
template <bool SAMPLE> __device__ __forceinline__ void attn_item(const Args& a, unsigned char* shm, int j, int b, int h, int q0) {
    const int tid = fresh_tid(), wid = __builtin_amdgcn_readfirstlane(tid >> 6), lane = tid & 63, r32 = lane & 31, hi = lane >> 5;
    char* V_lds = (char*)shm; char* K_lds = (char*)shm + 2 * SHM_T; volatile LAS unsigned* flags = (volatile LAS unsigned*)((LAS unsigned char*)shm + 4 * SHM_T);
    const bf16* QB = (const bf16*)(a.ws + WS_QB); const bf16* GB = (const bf16*)(a.ws + WS_GB); bf16* OG = (bf16*)(a.ws + WS_OG);
    const int qbw = SAMPLE ? PAST : q0 + 32 * wid;
    const int qpos = qbw + r32;
    const size_t qrow = SAMPLE ? (size_t)(MP + b * TS + r32) : (size_t)(b * TP + qpos);
    bool done = SAMPLE ? (wid != 0) : false;
    bf16x8 qr[8];
#pragma unroll
    for (int d0 = 0; d0 < 8; ++d0) qr[d0] = *(const bf16x8*)(QB + hm((int)qrow, h) + d0 * 16 + hi * 8);
    f32x16 o[4] = {}; float C = 1.f;
    const int ptop = SAMPLE ? PAST - 32 : q0 + 192, ntiles = SAMPLE ? 33 : ptop / 64 + 1;
    const int sr = tid >> 4, sc = (tid & 15) * 8, vb0 = (int)(uintptr_t)V_lds + v_rd_base(lane);
    if (tid < 16) flags[tid] = 0u;
    Stg st; load_kv<SAMPLE>(a, j, b, h, ptop, sr, sc, st);
    write_kv(V_lds, K_lds, 0, sr, sc, st);
    StgF sf;
    if (SAMPLE) load_cache(a, j, b, h, ptop - 64, sr, sc, sf); else if (ntiles > 1) load_kv<SAMPLE>(a, j, b, h, ptop - 64, sr, sc, st);
    WG_BAR();
    for (int ti = 0;; ++ti) {
        const int pb = ptop - 64 * ti, cur = ti & 1;
        if (!done && pb < qbw + 31) {
            f32x16 p0, p1;
            qkt(p0, p1, K_lds + cur * SHM_T, qr, r32, hi);
            if (pb + 63 < qbw && (!SAMPLE || pb >= 0)) { C = sb_half<SAMPLE, false>(p1, C, pb + 32, qpos, hi); C = sb_half<SAMPLE, false>(p0, C, pb, qpos, hi); }
            else { C = sb_half<SAMPLE, true>(p1, C, pb + 32, qpos, hi); C = sb_half<SAMPLE, true>(p0, C, pb, qpos, hi); }
            bf16x8 pa0, pa1, pa2, pa3;
            ATT_PK4(p0, 0, pa0); ATT_PK4(p0, 8, pa1); ATT_PK4(p1, 0, pa2); ATT_PK4(p1, 8, pa3);
            const int vb = vb0 + cur * SHM_T;
            pv_one<0>(o[0], vb, pa0, pa1, pa2, pa3); pv_one<1>(o[1], vb, pa0, pa1, pa2, pa3); pv_one<2>(o[2], vb, pa0, pa1, pa2, pa3); pv_one<3>(o[3], vb, pa0, pa1, pa2, pa3);
            done = __all(C < SB_EXIT_LIN);
        }
        const bool more = ti + 1 < ntiles;
        if (SAMPLE) { if (more) write_kvf(V_lds, K_lds, cur ^ 1, sr, sc, sf); load_cache(a, j, b, h, ptop - 64 * min(ti + 2, ntiles - 1), sr, sc, sf); }
        else { if (more) write_kv(V_lds, K_lds, cur ^ 1, sr, sc, st);
            if (ti + 2 < ntiles) load_kv<SAMPLE>(a, j, b, h, ptop - 64 * (ti + 2), sr, sc, st); }
        if (lane == 0) flags[cur * 8 + wid] = done ? 1u : 0u;
        WG_BAR();
        if (!more) break;
        unsigned nd = 0;
#pragma unroll
        for (int w = 0; w < 8; ++w) nd += flags[cur * 8 + w];
        if (nd == 8u) break;
    }
    if (!SAMPLE || wid == 0) {
        const size_t row0 = SAMPLE ? (size_t)(MP + b * TS) : (size_t)(b * TP + qbw);
        u32x4 egt[8], ekk[8], evv[8];
#pragma unroll
        for (int i = 0; i < 8; ++i) { const size_t ho = hm((int)row0 + 4 * i + (lane >> 4), h) + (lane & 15) * 8;
            egt[i] = *(const u32x4*)(GB + ho); if (SAMPLE) { ekk[i] = *(const u32x4*)((const bf16*)(a.ws + WS_KB) + ho); evv[i] = *(const u32x4*)((const bf16*)(a.ws + WS_VB) + ho); } }
        float* ol = (float*)(shm + wid * 16384);
#pragma unroll
        for (int d0 = 0; d0 < 4; ++d0)
#pragma unroll
            for (int g = 0; g < 4; ++g) *(f32x4*)(ol + r32 * 128 + (((8 * d0 + 2 * g + hi) ^ r32) << 2)) = (f32x4){o[d0][4 * g + 0], o[d0][4 * g + 1], o[d0][4 * g + 2], o[d0][4 * g + 3]};
        asm volatile("s_waitcnt lgkmcnt(0)" ::: "memory");
#pragma unroll
        for (int i = 0; i < 8; ++i) { const int q = 4 * i + (lane >> 4), c = (lane & 15) * 8; const size_t idx = (row0 + q) * D + h * HD + c;
            const u32x4 gt = egt[i]; const f32x4 x0 = *(const f32x4*)(ol + q * 128 + ((((c >> 2)) ^ q) << 2)), x1 = *(const f32x4*)(ol + q * 128 + ((((c >> 2) + 1) ^ q) << 2));
            u32x4 w; w.x = cvtpk(x0.x * bflo(gt.x), x0.y * bfhi(gt.x)); w.y = cvtpk(x0.z * bflo(gt.y), x0.w * bfhi(gt.y)); w.z = cvtpk(x1.x * bflo(gt.z), x1.y * bfhi(gt.z)); w.w = cvtpk(x1.z * bflo(gt.w), x1.w * bfhi(gt.w));
            *(u32x4*)(OG + idx) = w;
            if (SAMPLE) {
                const u32x4 kk = ekk[i], vv = evv[i];
                const size_t so = (size_t)j * MS * D + (idx - (size_t)MP * D); float* ko = a.out + O_KS + so; float* vo = a.out + O_VS + so;
                *(f32x4*)ko = (f32x4){bflo(kk.x), bfhi(kk.x), bflo(kk.y), bfhi(kk.y)}; *(f32x4*)(ko + 4) = (f32x4){bflo(kk.z), bfhi(kk.z), bflo(kk.w), bfhi(kk.w)};
                *(f32x4*)vo = (f32x4){bflo(vv.x), bfhi(vv.x), bflo(vv.y), bfhi(vv.y)}; *(f32x4*)(vo + 4) = (f32x4){bflo(vv.z), bfhi(vv.z), bflo(vv.w), bfhi(vv.w)}; } }
    }
    __syncthreads();
}
__device__ __forceinline__ void attn_item3(const Args& a, unsigned char* shm, int j, int b, int h, int q0) {
    const int tid = fresh_tid(), wid = __builtin_amdgcn_readfirstlane(tid >> 6), lane = tid & 63, r32 = lane & 31, hi = lane >> 5;
    volatile LAS unsigned* flags = (volatile LAS unsigned*)((LAS unsigned char*)shm + 6 * SHM_T);
    const bf16* QB = (const bf16*)(a.ws + WS_QB); const bf16* GB = (const bf16*)(a.ws + WS_GB); bf16* OG = (bf16*)(a.ws + WS_OG);
    const int qbw = q0 + 32 * wid, qpos = qbw + r32;
    const size_t qrow = (size_t)(b * TP + qpos);
    bool done = false;
    bf16x8 qr[8];
#pragma unroll
    for (int d0 = 0; d0 < 8; ++d0) qr[d0] = *(const bf16x8*)(QB + hm((int)qrow, h) + d0 * 16 + hi * 8);
    f32x16 o[4] = {}; float C = 1.f;
    const int ptop = q0 + 192, ntiles = ptop / 64 + 1;
    const int vbl = (int)(uintptr_t)shm + v_rd_base(lane);
    if (tid < 16) flags[tid] = 0u;
    const bool isK = wid >= 4; const int cb0 = 4 * (wid & 3);
    unsigned offs[4];
#pragma unroll
    for (int i = 0; i < 4; ++i) { const int cb = cb0 + i; int row, col;
        if (isK) { row = cb * 4 + (lane >> 4); const int colB = ((lane & 15) * 16) ^ ((row & 7) << 4); col = colB >> 1; }
        else { const int sb = cb * 2 + (lane >> 5), kk = (sb >> 2) * 8 + ((lane & 31) >> 2); row = (kk & ~0xC) | ((kk & 4) << 1) | ((kk & 8) >> 1); col = (sb & 3) * 32 + (lane & 3) * 8; }
        offs[i] = (unsigned)(row * HD + col); }
    const bf16* src0 = (isK ? (const bf16*)(a.ws + WS_KB) : (const bf16*)(a.ws + WS_VB)) + hm(b * TP, h);
    unsigned char* dst0 = shm + (isK ? SHM_T : 0) + cb0 * 1024;
#define ATT_DMA(slot, pb_) do { const bf16* s_ = src0 + (size_t)(pb_) * HD; LAS unsigned* d_ = (LAS unsigned*)(LAS unsigned char*)(dst0 + (slot) * 2 * SHM_T); \
        _Pragma("unroll") for (int i_ = 0; i_ < 4; ++i_) __builtin_amdgcn_global_load_lds((const unsigned*)(s_ + offs[i_]), d_ + i_ * 256, 16, 0, 0); } while (0)
    ATT_DMA(0, ptop);
    if (ntiles > 1) ATT_DMA(1, ptop - 64);
    int s = 0;
    for (int ti = 0; ti < ntiles; ++ti) {
        const int pb = ptop - 64 * ti;
        if (ti + 1 < ntiles) asm volatile("s_waitcnt vmcnt(4)" ::: "memory"); else asm volatile("s_waitcnt vmcnt(0)" ::: "memory");
        WG_BAR();
        if (ti > 0) { unsigned nd = 0;
#pragma unroll
            for (int w = 0; w < 8; ++w) nd += flags[((ti - 1) & 1) * 8 + w];
            if (nd == 8u) break; }
        if (ti + 2 < ntiles) { const int s2 = s >= 1 ? s - 1 : 2; ATT_DMA(s2, pb - 128); }
        if (!done && pb < qbw + 31) {
            f32x16 p0, p1;
            qkt(p0, p1, (const char*)shm + (2 * s + 1) * SHM_T, qr, r32, hi);
            if (pb + 63 < qbw) { C = sb_half<false, false>(p1, C, pb + 32, qpos, hi); C = sb_half<false, false>(p0, C, pb, qpos, hi); }
            else { C = sb_half<false, true>(p1, C, pb + 32, qpos, hi); C = sb_half<false, true>(p0, C, pb, qpos, hi); }
            bf16x8 pa0, pa1, pa2, pa3;
            ATT_PK4(p0, 0, pa0); ATT_PK4(p0, 8, pa1); ATT_PK4(p1, 0, pa2); ATT_PK4(p1, 8, pa3);
            const int vb = vbl + 2 * s * SHM_T;
            pv_one<0>(o[0], vb, pa0, pa1, pa2, pa3); pv_one<1>(o[1], vb, pa0, pa1, pa2, pa3); pv_one<2>(o[2], vb, pa0, pa1, pa2, pa3); pv_one<3>(o[3], vb, pa0, pa1, pa2, pa3);
            done = __all(C < SB_EXIT_LIN);
        }
        if (lane == 0) flags[(ti & 1) * 8 + wid] = done ? 1u : 0u;
        s = s == 2 ? 0 : s + 1;
    }
#undef ATT_DMA
    u32x4 egt[8], ekk[8], evv[8];
#pragma unroll
    for (int i = 0; i < 8; ++i) { const size_t ho = hm(b * TP + qbw + 4 * i + (lane >> 4), h) + (lane & 15) * 8;
        egt[i] = *(const u32x4*)(GB + ho); ekk[i] = *(const u32x4*)((const bf16*)(a.ws + WS_KB) + ho); evv[i] = *(const u32x4*)((const bf16*)(a.ws + WS_VB) + ho); }
    asm volatile("s_waitcnt vmcnt(0)" ::: "memory");
    WG_BAR();
    {
        float* ol = (float*)(shm + wid * 16384);
#pragma unroll
        for (int d0 = 0; d0 < 4; ++d0)
#pragma unroll
            for (int g = 0; g < 4; ++g) *(f32x4*)(ol + r32 * 128 + (((8 * d0 + 2 * g + hi) ^ r32) << 2)) = (f32x4){o[d0][4 * g + 0], o[d0][4 * g + 1], o[d0][4 * g + 2], o[d0][4 * g + 3]};
        asm volatile("s_waitcnt lgkmcnt(0)" ::: "memory");
        const size_t row0 = (size_t)(b * TP + qbw);
#pragma unroll
        for (int i = 0; i < 8; ++i) { const int q = 4 * i + (lane >> 4), c = (lane & 15) * 8; const size_t idx = (row0 + q) * D + h * HD + c;
            const u32x4 gt = egt[i]; const f32x4 x0 = *(const f32x4*)(ol + q * 128 + ((((c >> 2)) ^ q) << 2)), x1 = *(const f32x4*)(ol + q * 128 + ((((c >> 2) + 1) ^ q) << 2));
            u32x4 w; w.x = cvtpk(x0.x * bflo(gt.x), x0.y * bfhi(gt.x)); w.y = cvtpk(x0.z * bflo(gt.y), x0.w * bfhi(gt.y)); w.z = cvtpk(x1.x * bflo(gt.z), x1.y * bfhi(gt.z)); w.w = cvtpk(x1.z * bflo(gt.w), x1.w * bfhi(gt.w));
            *(u32x4*)(OG + idx) = w;
            const u32x4 kk = ekk[i], vv = evv[i];
            float* ko = a.out + O_KP + (size_t)j * MP * D + idx; float* vo = a.out + O_VP + (size_t)j * MP * D + idx;
            *(f32x4*)ko = (f32x4){bflo(kk.x), bfhi(kk.x), bflo(kk.y), bfhi(kk.y)}; *(f32x4*)(ko + 4) = (f32x4){bflo(kk.z), bfhi(kk.z), bflo(kk.w), bfhi(kk.w)};
            *(f32x4*)vo = (f32x4){bflo(vv.x), bfhi(vv.x), bflo(vv.y), bfhi(vv.y)}; *(f32x4*)(vo + 4) = (f32x4){bflo(vv.z), bfhi(vv.z), bflo(vv.w), bfhi(vv.w)}; }
    }
    __syncthreads();
}
}
__device__ __forceinline__ void ph_attn(const Args& a, unsigned char* shm, int bid, int nblk, int layer) {
    const int j = layer >> 1;
    for (int it = bid; it < BP * NH * (TP / 256) + BS * NH; it += nblk) {
        if (it < BP * NH * (TP / 256)) att::attn_item3(a, shm, j, it >> 8, (it >> 4) & 15, (it & 15) * 256);
        else { const int u = it - BP * NH * (TP / 256); att::attn_item<true>(a, shm, j, u >> 4, u & 15, 0); }
    }
}


namespace hg {
using bf16x8 = __attribute__((ext_vector_type(8))) short;
using s16x4  = __attribute__((ext_vector_type(4))) short;
constexpr int T_QH = 0, T_KD = 8192, T_KT = 16384, T_V = 24576, T_TOT = 32768, T_DEC = T_TOT + 8 * 128 * 4, BUFSZ = T_DEC + 512, T_P = 2 * BUFSZ, PST = 80, T_O = T_P + 32 * PST, OST = 132, T_END = T_O + 32 * OST * 4;
static_assert(BUFSZ % 16 == 0 && T_P % 16 == 0 && T_O % 16 == 0 && T_END <= 131072, "hgrn LDS map");
constexpr int SEG = 1024, NSEG = TP / SEG;
constexpr size_t HL_DG = (size_t)BP * NH * (NSEG - 1) * HD * HD * 4;
__device__ __forceinline__ unsigned off_b(unsigned row, unsigned ch) { return 256u * row + 16u * (ch ^ (((row & 3) << 2) | ((row >> 2) & 3))); }
__device__ __forceinline__ unsigned row_read_addr_16(unsigned lane, unsigned rb, unsigned s) { return off_b((lane & 15) + 16 * rb, 4 * s + (lane >> 4)); }
__device__ __forceinline__ unsigned tr_read_addr_16(unsigned lane, unsigned c, unsigned t) {
    const unsigned g = lane >> 4, q = (lane & 15) >> 2, p = lane & 3; return off_b(8 * g + 4 * t + q, 2 * c + (p >> 1)) + 8 * (p & 1); }
__device__ __forceinline__ unsigned cvtpk(float lo, float hi) { unsigned r; asm volatile("v_cvt_pk_bf16_f32 %0, %1, %2" : "=v"(r) : "v"(lo), "v"(hi)); return r; }
__device__ __forceinline__ s16x4 tr_ld(unsigned addr) { s16x4 r; asm volatile("ds_read_b64_tr_b16 %0, %1" : "=&v"(r) : "v"(addr) : "memory"); return r; }
#define HG_LGKM0() do { asm volatile("s_waitcnt lgkmcnt(0)" ::: "memory"); __builtin_amdgcn_sched_barrier(0); } while (0)
#define HG_CAT(L, H) (bf16x8){L[0], L[1], L[2], L[3], H[0], H[1], H[2], H[3]}
__device__ __forceinline__ f32x4 mfma16(bf16x8 a, bf16x8 b, f32x4 c) { return __builtin_amdgcn_mfma_f32_16x16x32_bf16(a, b, c, 0, 0, 0); }

typedef _Float16 h16x2 __attribute__((ext_vector_type(2)));
struct Pre { unsigned lh[4]; unsigned qv[4]; u32x4 vv, gv; };
template <bool FULL> __device__ __forceinline__ void load_chunk(const Args& a, int r0, int h, int tid, Pre& p) {
    const int lane = tid & 63, w = tid >> 6;
    const bf16* QB = (const bf16*)(a.ws + WS_QB); const bf16* VB = (const bf16*)(a.ws + WS_VB); const bf16* GB = (const bf16*)(a.ws + WS_GB); const unsigned short* LF = (const unsigned short*)(a.ws + WS_LF);
#pragma unroll
    for (int i = 0; i < 4; ++i) { const size_t idx = hm(r0 + 4 * w + i, h) + 2 * lane; p.lh[i] = *(const unsigned*)(LF + idx); if (FULL) p.qv[i] = *(const unsigned*)(QB + idx); }
    const size_t vidx = hm(r0 + (tid >> 4), h) + 8 * (tid & 15);
    p.vv = *(const u32x4*)(VB + vidx); if (FULL) p.gv = *(const u32x4*)(GB + vidx);
}
struct StA { f32x2 l[4], c[4]; unsigned qv[4]; };
template <bool FULL> __device__ __forceinline__ void stageA(unsigned char* bufp, int tid, const Pre& p, StA& sa, u32x4& gv) {
    const int lane = tid & 63, w = __builtin_amdgcn_readfirstlane(tid >> 6);
#pragma unroll
    for (int i = 0; i < 4; ++i) { const h16x2 lv = __builtin_bit_cast(h16x2, p.lh[i]); sa.l[i] = (f32x2){(float)lv.x, (float)lv.y} * LOG2E; if (FULL) sa.qv[i] = p.qv[i]; }
    if (FULL) gv = p.gv;
    sa.c[0] = sa.l[0]; sa.c[1] = sa.c[0] + sa.l[1]; sa.c[2] = sa.c[1] + sa.l[2]; sa.c[3] = sa.c[2] + sa.l[3];
    *(f32x2*)(bufp + T_TOT + (w * 128 + 2 * lane) * 4) = sa.c[3];
    *(u32x4*)(bufp + T_V + off_b(tid >> 4, tid & 15)) = p.vv;
}
template <bool FULL> __device__ __forceinline__ void stageB(unsigned char* bufp, int tid, const StA& sa, f32x2& dsum) {
    const int lane = tid & 63, w = __builtin_amdgcn_readfirstlane(tid >> 6);
    f32x2 pre = {0.f, 0.f}, bl = {0.f, 0.f};
#pragma unroll
    for (int ww = 0; ww < 8; ++ww) { const f32x2 t = *(const f32x2*)(bufp + T_TOT + (ww * 128 + 2 * lane) * 4); if (ww < w) pre += t; bl += t; }
#pragma unroll
    for (int i = 0; i < 4; ++i) {
        const f32x2 b = pre + sa.c[i];
        const float k0 = 1.0f - __builtin_amdgcn_exp2f(sa.l[i].x), k1 = 1.0f - __builtin_amdgcn_exp2f(sa.l[i].y);
        const unsigned addr = off_b(4 * w + i, lane >> 2) + (lane & 3) * 4;
        *(unsigned*)(bufp + T_KT + addr) = cvtpk(k0 * __builtin_amdgcn_exp2f(bl.x - b.x), k1 * __builtin_amdgcn_exp2f(bl.y - b.y));
        if (FULL) {
            *(unsigned*)(bufp + T_QH + addr) = cvtpk(bflo(sa.qv[i]) * __builtin_amdgcn_exp2f(b.x), bfhi(sa.qv[i]) * __builtin_amdgcn_exp2f(b.y));
            *(unsigned*)(bufp + T_KD + addr) = cvtpk(k0 * __builtin_amdgcn_exp2f(fminf(-b.x, 115.f)), k1 * __builtin_amdgcn_exp2f(fminf(-b.y, 115.f)));
        }
    }
    if (w == 0) { f32x2 e; e.x = __builtin_amdgcn_exp2f(bl.x); e.y = __builtin_amdgcn_exp2f(bl.y); *(f32x2*)(bufp + T_DEC + 2 * lane * 4) = e; }
    dsum += bl;
}
__device__ __forceinline__ bf16x8 load_vfrag(unsigned char* bufp, int tid) {
    const int lane = tid & 63, w = __builtin_amdgcn_readfirstlane(tid >> 6); const unsigned lds0 = (unsigned)(uintptr_t)bufp;
    const s16x4 vlo = tr_ld(lds0 + T_V + tr_read_addr_16(lane, w, 0)), vhi = tr_ld(lds0 + T_V + tr_read_addr_16(lane, w, 1));
    HG_LGKM0();
    return HG_CAT(vlo, vhi);
}
__device__ __forceinline__ void stageC(unsigned char* shm, unsigned char* bufp, int tid, const f32x4 (&S)[8], f32x4 (&o)[2]) {
    const int lane = tid & 63, w = __builtin_amdgcn_readfirstlane(tid >> 6), g = lane >> 4, l15 = lane & 15;
    o[0] = (f32x4){0.f, 0.f, 0.f, 0.f}; o[1] = (f32x4){0.f, 0.f, 0.f, 0.f};
    if (w < 3) {
        const int rb = w > 0 ? 1 : 0, cb = w == 2 ? 1 : 0; f32x4 sc = {0.f, 0.f, 0.f, 0.f};
#pragma unroll
        for (int ks = 0; ks < 4; ++ks) { const bf16x8 A = *(const bf16x8*)(bufp + T_QH + row_read_addr_16(lane, rb, ks)), B = *(const bf16x8*)(bufp + T_KD + row_read_addr_16(lane, cb, ks)); sc = mfma16(A, B, sc); }
#pragma unroll
        for (int i = 0; i < 4; ++i) { const int tl = 4 * g + i; const float v = (rb != cb || l15 <= tl) ? sc[i] : 0.f;
            *(unsigned short*)(shm + T_P + (16 * rb + tl) * PST + (16 * cb + l15) * 2) = (unsigned short)f2bf(v); }
    }
#pragma unroll
    for (int ks = 0; ks < 4; ++ks) {
        u32x4 bw = {cvtpk(S[2 * ks][0], S[2 * ks][1]), cvtpk(S[2 * ks][2], S[2 * ks][3]), cvtpk(S[2 * ks + 1][0], S[2 * ks + 1][1]), cvtpk(S[2 * ks + 1][2], S[2 * ks + 1][3])};
        const bf16x8 Bf = *reinterpret_cast<bf16x8*>(&bw);
#pragma unroll
        for (int rb = 0; rb < 2; ++rb) { const unsigned t = l15 + 16 * rb;
            const u32x2 alo = *(const u32x2*)(bufp + T_QH + off_b(t, 4 * ks + (g >> 1)) + 8 * (g & 1)), ahi = *(const u32x2*)(bufp + T_QH + off_b(t, 4 * ks + 2 + (g >> 1)) + 8 * (g & 1));
            u32x4 aw = {alo.x, alo.y, ahi.x, ahi.y}; o[rb] = mfma16(*reinterpret_cast<bf16x8*>(&aw), Bf, o[rb]); }
    }
}
template <bool FULL> __device__ __forceinline__ void stageD(unsigned char* shm, unsigned char* bufp, int tid, f32x4 (&S)[8], f32x4 (&o)[2]) {
    const int lane = tid & 63, w = __builtin_amdgcn_readfirstlane(tid >> 6), g = lane >> 4, l15 = lane & 15; const unsigned lds0 = (unsigned)(uintptr_t)bufp;
    const bf16x8 vf = load_vfrag(bufp, tid);
    if (FULL) {
#pragma unroll
        for (int rb = 0; rb < 2; ++rb) { const bf16x8 A = *(const bf16x8*)(shm + T_P + (l15 + 16 * rb) * PST + 16 * g); o[rb] = mfma16(A, vf, o[rb]); }
#pragma unroll
        for (int rb = 0; rb < 2; ++rb)
#pragma unroll
            for (int i = 0; i < 4; ++i) *(float*)(shm + T_O + ((16 * rb + 4 * g + i) * OST + 16 * w + l15) * 4) = o[rb][i];
    }
#pragma unroll
    for (int kt = 0; kt < 8; kt += 2) {
        const s16x4 k0l = tr_ld(lds0 + T_KT + tr_read_addr_16(lane, kt, 0)), k0h = tr_ld(lds0 + T_KT + tr_read_addr_16(lane, kt, 1));
        const s16x4 k1l = tr_ld(lds0 + T_KT + tr_read_addr_16(lane, kt + 1, 0)), k1h = tr_ld(lds0 + T_KT + tr_read_addr_16(lane, kt + 1, 1));
        const f32x4 d0 = *(const f32x4*)(bufp + T_DEC + (16 * kt + 4 * g) * 4), d1 = *(const f32x4*)(bufp + T_DEC + (16 * (kt + 1) + 4 * g) * 4);
        HG_LGKM0();
        S[kt] = mfma16(HG_CAT(k0l, k0h), vf, S[kt] * d0); S[kt + 1] = mfma16(HG_CAT(k1l, k1h), vf, S[kt + 1] * d1);
    }
}
__device__ __forceinline__ void stageE(const Args& a, unsigned char* shm, int tid, int r0, int h, int jl, const u32x4 gv) {
    const int vrow = tid >> 4, vch = tid & 15, c0 = 8 * vch; const float* hw = a.in[10] + jl * HD + c0; bf16* OG = (bf16*)(a.ws + WS_OG);
    const f32x4 x0 = *(const f32x4*)(shm + T_O + (vrow * OST + c0) * 4), x1 = *(const f32x4*)(shm + T_O + (vrow * OST + c0 + 4) * 4);
    float ss = (x0.x * x0.x + x0.y * x0.y) + (x0.z * x0.z + x0.w * x0.w) + (x1.x * x1.x + x1.y * x1.y) + (x1.z * x1.z + x1.w * x1.w);
    ss += __shfl_xor(ss, 1); ss += __shfl_xor(ss, 2); ss += __shfl_xor(ss, 4); ss += __shfl_xor(ss, 8);
    const float rn = __builtin_amdgcn_rsqf(ss * (1.0f / HD) + EPS); const f32x4 h0 = *(const f32x4*)hw, h1 = *(const f32x4*)(hw + 4);
    u32x4 wv;
    wv.x = cvtpk(x0.x * rn * h0.x * bflo(gv.x), x0.y * rn * h0.y * bfhi(gv.x)); wv.y = cvtpk(x0.z * rn * h0.z * bflo(gv.y), x0.w * rn * h0.w * bfhi(gv.y));
    wv.z = cvtpk(x1.x * rn * h1.x * bflo(gv.z), x1.y * rn * h1.y * bfhi(gv.z)); wv.w = cvtpk(x1.z * rn * h1.z * bflo(gv.w), x1.w * rn * h1.w * bfhi(gv.w));
    *(u32x4*)(OG + (size_t)(r0 + vrow) * D + h * HD + c0) = wv;
}
template <bool FULL> __device__ __forceinline__ void run_chunks(const Args& a, unsigned char* shm, int r0, int nst, int h, int jl, f32x4 (&S)[8], f32x2& dsum, int tid) {
    Pre pA, pB; StA sa; u32x4 gvA = {0u, 0u, 0u, 0u}, gvB = {0u, 0u, 0u, 0u}; f32x4 o[2];
    load_chunk<FULL>(a, r0, h, tid, pA); if (nst > 1) load_chunk<FULL>(a, r0 + 32, h, tid, pB);
    stageA<FULL>(shm, tid, pA, sa, gvA); if (nst > 2) load_chunk<FULL>(a, r0 + 64, h, tid, pA);
    WG_BAR();
    stageB<FULL>(shm, tid, sa, dsum);
    WG_BAR();
#define HG_TURN(M, BC, BN, PN, GN, GE) do { const int m_ = (M); \
        if (FULL) { if (m_ > 0) stageE(a, shm, tid, r0 + 32 * (m_ - 1), h, jl, GE); stageC(shm, shm + (BC) * BUFSZ, tid, S, o); } \
        else stageD<false>(shm, shm + (BC) * BUFSZ, tid, S, o); \
        if (m_ + 1 < nst) { stageA<FULL>(shm + (BN) * BUFSZ, tid, PN, sa, GN); if (m_ + 3 < nst) load_chunk<FULL>(a, r0 + 32 * (m_ + 3), h, tid, PN); } \
        WG_BAR(); \
        if (FULL) stageD<true>(shm, shm + (BC) * BUFSZ, tid, S, o); \
        if (m_ + 1 < nst) stageB<FULL>(shm + (BN) * BUFSZ, tid, sa, dsum); \
        WG_BAR(); } while (0)
    for (int m = 0; m < nst; m += 2) {
        HG_TURN(m, 0, 1, pB, gvB, gvB);
        if (m + 1 < nst) HG_TURN(m + 1, 1, 0, pA, gvA, gvA);
    }
#undef HG_TURN
    if (FULL) stageE(a, shm, tid, r0 + 32 * (nst - 1), h, jl, ((nst - 1) & 1) ? gvB : gvA);
}
__device__ __forceinline__ size_t st_off(int kt, int i, int g, int w, int l15) { return (size_t)(16 * kt + 4 * g + i) * HD + 16 * w + l15; }

__device__ __forceinline__ void unit_pass1(const Args& a, unsigned char* shm, int jl, int b, int h, int seg) {
    const int tid = fresh_tid(), lane = tid & 63, w = __builtin_amdgcn_readfirstlane(tid >> 6), g = lane >> 4, l15 = lane & 15;
    f32x4 S[8];
#pragma unroll
    for (int kt = 0; kt < 8; ++kt) S[kt] = (f32x4){0.f, 0.f, 0.f, 0.f};
    f32x2 dsum = {0.f, 0.f};
    run_chunks<false>(a, shm, b * TP + seg * SEG, SEG / 32, h, jl, S, dsum, tid);
    float* L = (float*)(a.ws + WS_HL) + (size_t)((b * NH + h) * (NSEG - 1) + seg) * HD * HD;
#pragma unroll
    for (int kt = 0; kt < 8; ++kt)
#pragma unroll
        for (int i = 0; i < 4; ++i) L[st_off(kt, i, g, w, l15)] = S[kt][i];
    if (w == 0) *(f32x2*)((float*)(a.ws + WS_HL + HL_DG) + (size_t)((b * NH + h) * (NSEG - 1) + seg) * HD + 2 * lane) = dsum;
}
__device__ __forceinline__ void unit_pass2(const Args& a, unsigned char* shm, int jl, bool prompt, int b, int h, int seg) {
    const int tid = fresh_tid(), lane = tid & 63, w = __builtin_amdgcn_readfirstlane(tid >> 6), g = lane >> 4, l15 = lane & 15;
    f32x4 S[8];
#pragma unroll
    for (int kt = 0; kt < 8; ++kt) S[kt] = (f32x4){0.f, 0.f, 0.f, 0.f};
    if (prompt) {
        for (int sp = 0; sp < seg; ++sp) {
            const float* L = (const float*)(a.ws + WS_HL) + (size_t)((b * NH + h) * (NSEG - 1) + sp) * HD * HD;
            const float* Dg = (const float*)(a.ws + WS_HL + HL_DG) + (size_t)((b * NH + h) * (NSEG - 1) + sp) * HD;
#pragma unroll
            for (int kt = 0; kt < 8; ++kt) { const f32x4 dg = *(const f32x4*)(Dg + 16 * kt + 4 * g);
#pragma unroll
                for (int i = 0; i < 4; ++i) S[kt][i] = S[kt][i] * __builtin_amdgcn_exp2f(dg[i]) + L[st_off(kt, i, g, w, l15)]; }
        }
    } else {
        const float* S0 = a.in[4] + ((size_t)(jl * BS + b) * NH + h) * HD * HD;
#pragma unroll
        for (int kt = 0; kt < 8; ++kt)
#pragma unroll
            for (int i = 0; i < 4; ++i) S[kt][i] = S0[st_off(kt, i, g, w, l15)];
    }
    for (int u = tid; u < 32 * PST / 4; u += 512) ((unsigned*)(shm + T_P))[u] = 0u;
    f32x2 dsum = {0.f, 0.f};
    const int nst = prompt ? SEG / 32 : TS / 32, r0 = prompt ? b * TP + seg * SEG : MP + b * TS;
    run_chunks<true>(a, shm, r0, nst, h, jl, S, dsum, tid);
    if (!prompt || seg == NSEG - 1) {
        float* So = prompt ? a.out + O_SP + ((size_t)(jl * BP + b) * NH + h) * HD * HD : a.out + O_SS + ((size_t)(jl * BS + b) * NH + h) * HD * HD;
#pragma unroll
        for (int kt = 0; kt < 8; ++kt)
#pragma unroll
            for (int i = 0; i < 4; ++i) So[st_off(kt, i, g, w, l15)] = S[kt][i];
    }
    __syncthreads();
}
}
__device__ __forceinline__ void ph_hgrn1(const Args& a, unsigned char* shm, int bid, int nblk, int layer) {
    for (int it = bid; it < BP * NH * (hg::NSEG - 1); it += nblk) { const int seg = it % (hg::NSEG - 1), bh = it / (hg::NSEG - 1); hg::unit_pass1(a, shm, layer >> 1, bh / NH, bh % NH, seg); }
}
__device__ __forceinline__ void ph_hgrn2(const Args& a, unsigned char* shm, int bid, int nblk, int layer) {
    for (int it = bid; it < BP * NH * hg::NSEG + BS * NH; it += nblk) {
        if (it < BP * NH * hg::NSEG) { const int seg = it % hg::NSEG, bh = it / hg::NSEG; hg::unit_pass2(a, shm, layer >> 1, true, bh / NH, bh % NH, seg); }
        else { const int u = it - BP * NH * hg::NSEG; hg::unit_pass2(a, shm, layer >> 1, false, u / NH, u % NH, 0); }
    }
}


#define EPI_BAR() do { asm volatile("s_waitcnt lgkmcnt(0)" ::: "memory"); __builtin_amdgcn_s_barrier(); asm volatile("" ::: "memory"); } while (0)
__device__ __forceinline__ u32x4 pack8(const f32x4 a, const f32x4 b) { u32x4 w; w.x = pg8::cvt_pk_bf16(a.x, a.y); w.y = pg8::cvt_pk_bf16(a.z, a.w); w.z = pg8::cvt_pk_bf16(b.x, b.y); w.w = pg8::cvt_pk_bf16(b.z, b.w); return w; }
__device__ __forceinline__ f32x4 silu4(const f32x4 x) { f32x4 r; r.x = silu_f(x.x); r.y = silu_f(x.y); r.z = silu_f(x.z); r.w = silu_f(x.w); return r; }
__device__ __forceinline__ float sq4(const f32x4 x) { return (x.x * x.x + x.y * x.y) + (x.z * x.z + x.w * x.w); }

constexpr int RS_OFF = EPI_OFF + 8192, RS_TAG_OFF = RS_OFF + 1024;
static_assert(RS_TAG_OFF + 16 <= LDS_BYTES, "LDS map");
__device__ __forceinline__ const float* rstd_table(const float* ssq, float* scr, int row0, int nrows, int wr, int wc, int fr, int fq) {
    float* rs = scr + (RS_OFF - EPI_OFF) / 4; volatile LAS int* tag = (volatile LAS int*)((LAS float*)scr + (RS_TAG_OFF - EPI_OFF) / 4);
    if (__builtin_amdgcn_readfirstlane(*tag) != row0) {
        int t = (wr * 4 + wc) * 64 + fq * 16 + fr; asm volatile("" : "+v"(t));
        if (t < nrows) rs[t] = row_rstd(ssq, row0 + t);
        EPI_BAR();
        if (t == 0) *tag = row0;
        EPI_BAR();
    }
    return rs;
}
struct EpiG1Attn {
    static constexpr bool PERM = true, AFTER_DRAIN = false;
    const float* ssq; bf16* QB; bf16* KB; bf16* VB; bf16* GB; float* out; const float* qw; const float* kw; float* scr; int j;
    __device__ __forceinline__ void operator()(const pg8::f32x4 (&acc)[2][2][4][2], const pg8::Unit& u, int wr, int wc, int fr, int fq) const { run<2>(acc, u.pm * 256, u.pn, wr, wc, fr, fq, true); }
    template <int NAI> __device__ __forceinline__ void run(const pg8::f32x4 (&acc)[2][2][4][2], int row0, int pn, int wr, int wc, int fr, int fq, bool active) const {
        const int grp = pn >> 3, cD = 256 * (pn & 7) + 32 * wc + 8 * fq, rl0 = 64 * wr + fr, h0 = 2 * (pn & 7), dW = 32 * wc + 8 * fq; const bool prompt = row0 < MP;
        const float* rst = rstd_table(ssq, scr, row0, 128 * NAI, wr, wc, fr, fq);
        if (grp < 2) {
            if (active) {
#pragma unroll
                for (int ai = 0; ai < NAI; ++ai)
#pragma unroll
                    for (int m = 0; m < 4; ++m)
#pragma unroll
                        for (int bj = 0; bj < 2; ++bj) { float s = sq4(acc[ai][bj][m][0]) + sq4(acc[ai][bj][m][1]); s += __shfl_xor(s, 16); s += __shfl_xor(s, 32);
                            if (fq == 0) scr[((128 * ai + rl0 + 16 * m) * 2 + bj) * 4 + wc] = s; }
            }
            EPI_BAR();
            if (!active) return;
            const float* wp = (grp == 0 ? qw : kw) + 32 * wc + 8 * fq; const float gsc = grp == 0 ? QSCALE : 1.0f;
            const f32x4 w0 = *(const f32x4*)wp * gsc, w1 = *(const f32x4*)(wp + 4) * gsc;
            bf16* dst = grp == 0 ? QB : KB;
#pragma unroll
            for (int ai = 0; ai < NAI; ++ai)
#pragma unroll
                for (int m = 0; m < 4; ++m) { const int rl = 128 * ai + rl0 + 16 * m; const size_t ro = (size_t)(row0 + rl) * D + cD; const float r1 = rst[rl];
#pragma unroll
                    for (int bj = 0; bj < 2; ++bj) { const f32x4 t4 = *(const f32x4*)(scr + (rl * 2 + bj) * 4); const float tot = (t4.x + t4.y) + (t4.z + t4.w);
                        const float rn = r1 * __builtin_amdgcn_rsqf(r1 * r1 * tot * (1.0f / HD) + EPS);
                        const f32x4 v0 = acc[ai][bj][m][0] * rn * w0, v1 = acc[ai][bj][m][1] * rn * w1;
                        *(u32x4*)(dst + hm(row0 + rl, h0 + bj) + dW) = pack8(v0, v1);
                        }
                    asm volatile("" ::: "memory"); }
        } else if (grp == 2) {
            if (!active) return;
#pragma unroll
            for (int ai = 0; ai < NAI; ++ai)
#pragma unroll
                for (int m = 0; m < 4; ++m) { const int rl = 128 * ai + rl0 + 16 * m; const size_t ro = (size_t)(row0 + rl) * D + cD; const float r1 = rst[rl];
#pragma unroll
                    for (int bj = 0; bj < 2; ++bj) { const f32x4 v0 = acc[ai][bj][m][0] * r1, v1 = acc[ai][bj][m][1] * r1;
                        *(u32x4*)(VB + hm(row0 + rl, h0 + bj) + dW) = pack8(v0, v1);
                        }
                    asm volatile("" ::: "memory"); }
        } else {
            if (!active) return;
#pragma unroll
            for (int ai = 0; ai < NAI; ++ai)
#pragma unroll
                for (int m = 0; m < 4; ++m) { const int rl = 128 * ai + rl0 + 16 * m; const size_t ro = (size_t)(row0 + rl) * D + cD; const float r1 = rst[rl];
#pragma unroll
                    for (int bj = 0; bj < 2; ++bj) *(u32x4*)(GB + hm(row0 + rl, h0 + bj) + dW) = pack8(silu4(acc[ai][bj][m][0] * r1), silu4(acc[ai][bj][m][1] * r1));
                    asm volatile("" ::: "memory"); }
        }
    }
};
struct EpiG1Hgrn {
    static constexpr bool PERM = true, AFTER_DRAIN = false;
    const float* ssq; bf16* QB; unsigned short* LF; bf16* VB; bf16* GB; const float* oml; float* scr; bool lb0;
    __device__ __forceinline__ void operator()(const pg8::f32x4 (&acc)[2][2][4][2], const pg8::Unit& u, int wr, int wc, int fr, int fq) const { run<2>(acc, u.pm * 256, u.pn, wr, wc, fr, fq, true); }
    template <int NAI> __device__ __forceinline__ void run(const pg8::f32x4 (&acc)[2][2][4][2], int row0, int pn, int wr, int wc, int fr, int fq, bool active) const {
        const int grp = pn >> 3, cD = 256 * (pn & 7) + 32 * wc + 8 * fq, rl0 = 64 * wr + fr, h0 = 2 * (pn & 7), dW = 32 * wc + 8 * fq;
        const float* rst = rstd_table(ssq, scr, row0, 128 * NAI, wr, wc, fr, fq);
        if (!active) return;
        f32x4 om[2][2];
        if (grp == 1) {
#pragma unroll
            for (int bj = 0; bj < 2; ++bj) { om[bj][0] = *(const f32x4*)(oml + cD + 128 * bj); om[bj][1] = *(const f32x4*)(oml + cD + 128 * bj + 4); } }
#pragma unroll
        for (int ai = 0; ai < NAI; ++ai)
#pragma unroll
            for (int m = 0; m < 4; ++m) { const int rl = 128 * ai + rl0 + 16 * m; const size_t ro = (size_t)(row0 + rl) * D + cD; const float r1 = rst[rl];
#pragma unroll
                for (int bj = 0; bj < 2; ++bj) { const f32x4 v0 = acc[ai][bj][m][0] * r1, v1 = acc[ai][bj][m][1] * r1;
                    if (grp == 0) *(u32x4*)(QB + hm(row0 + rl, h0 + bj) + dW) = pack8(silu4(v0), silu4(v1));
                    else if (grp == 2) *(u32x4*)(VB + hm(row0 + rl, h0 + bj) + dW) = pack8(v0, v1);
                    else if (grp == 3) *(u32x4*)(GB + hm(row0 + rl, h0 + bj) + dW) = pack8(silu4(v0), silu4(v1));
                    else if (lb0) { f32x4 l0, l1;
                        const float kk = -LOG2E * r1;
#pragma unroll
                        for (int e = 0; e < 4; ++e) { l0[e] = fmaxf(-0.6931471805599453f * __builtin_amdgcn_logf(1.0f + __builtin_amdgcn_exp2f(acc[ai][bj][m][0][e] * kk)), -69.07755f);
                            l1[e] = fmaxf(-0.6931471805599453f * __builtin_amdgcn_logf(1.0f + __builtin_amdgcn_exp2f(acc[ai][bj][m][1][e] * kk)), -69.07755f); }
                        typedef _Float16 h16x2_ __attribute__((ext_vector_type(2)));
                        u32x4 lw; lw.x = __builtin_bit_cast(unsigned, (h16x2_){(_Float16)l0.x, (_Float16)l0.y}); lw.y = __builtin_bit_cast(unsigned, (h16x2_){(_Float16)l0.z, (_Float16)l0.w});
                        lw.z = __builtin_bit_cast(unsigned, (h16x2_){(_Float16)l1.x, (_Float16)l1.y}); lw.w = __builtin_bit_cast(unsigned, (h16x2_){(_Float16)l1.z, (_Float16)l1.w});
                        *(u32x4*)(LF + hm(row0 + rl, h0 + bj) + dW) = lw; }
                    else { f32x4 l0, l1;
#pragma unroll
                        for (int e = 0; e < 4; ++e) { const float m0 = om[bj][0][e], m1 = om[bj][1][e];
                            l0[e] = fminf(__builtin_amdgcn_logf(fmaxf(1.0f - m0, 1e-30f) + m0 * __builtin_amdgcn_rcpf(1.0f + __expf(-v0[e]))) * 0.6931471805599453f, 0.f); l1[e] = fminf(__builtin_amdgcn_logf(fmaxf(1.0f - m1, 1e-30f) + m1 * __builtin_amdgcn_rcpf(1.0f + __expf(-v1[e]))) * 0.6931471805599453f, 0.f); }
                        typedef _Float16 h16x2_ __attribute__((ext_vector_type(2)));
                        u32x4 lw; lw.x = __builtin_bit_cast(unsigned, (h16x2_){(_Float16)l0.x, (_Float16)l0.y}); lw.y = __builtin_bit_cast(unsigned, (h16x2_){(_Float16)l0.z, (_Float16)l0.w});
                        lw.z = __builtin_bit_cast(unsigned, (h16x2_){(_Float16)l1.x, (_Float16)l1.y}); lw.w = __builtin_bit_cast(unsigned, (h16x2_){(_Float16)l1.z, (_Float16)l1.w});
                        *(u32x4*)(LF + hm(row0 + rl, h0 + bj) + dW) = lw; } }
                asm volatile("" ::: "memory"); }
    }
};
template <bool BASE_F32, bool WRITE_Y> struct EpiG2 {
    static constexpr bool PERM = true, AFTER_DRAIN = false;
    const float* base_p; const float* base_s; float* out; bf16* XB; float* ssq; float* scr;
    __device__ __forceinline__ void operator()(const pg8::f32x4 (&acc)[2][2][4][2], const pg8::Unit& u, int wr, int wc, int fr, int fq) const { run<2>(acc, u.pm * 256, u.pn, wr, wc, fr, fq, true); }
    template <int NAI> __device__ __forceinline__ void run(const pg8::f32x4 (&acc)[2][2][4][2], int row0, int pn, int wr, int wc, int fr, int fq, bool active) const {
        const int c0 = 256 * pn + 32 * wc + 8 * fq, rl0 = 64 * wr + fr; const bool prompt = row0 < MP;
        if (active) {
            const size_t ro0 = (size_t)((prompt ? row0 : row0 - MP) + rl0) * D + c0;
            const float* bp = (prompt ? base_p : base_s) + ro0; float* op = (prompt ? out + O_YP : out + O_YS) + ro0;
            bf16* xb0 = XB + (size_t)(row0 + rl0) * D + c0;
            f32x4 pre[4][4]; u32x4 prh[4][2];
#define G2_LOAD(slot, q) do { const size_t ro_ = (size_t)(128 * ((q) >> 2) + 16 * ((q) & 3)) * D; \
                if (BASE_F32) { const float* p_ = bp + ro_; pre[slot][0] = *(const f32x4*)p_; pre[slot][1] = *(const f32x4*)(p_ + 4); pre[slot][2] = *(const f32x4*)(p_ + 128); pre[slot][3] = *(const f32x4*)(p_ + 132); } \
                else { prh[slot][0] = *(const u32x4*)(xb0 + ro_); prh[slot][1] = *(const u32x4*)(xb0 + ro_ + 128); } } while (0)
            G2_LOAD(0, 0); G2_LOAD(1, 1); if (NAI * 4 > 2) G2_LOAD(2, 2);
            asm volatile("" ::: "memory");
#pragma unroll
            for (int q = 0; q < 4 * NAI; ++q) { const int ai = q >> 2, m = q & 3, rl = 128 * ai + rl0 + 16 * m;
                if (q + 3 < 4 * NAI) G2_LOAD((q + 3) % 4, q + 3);
                asm volatile("" ::: "memory");
                const size_t ro = (size_t)(128 * ai + 16 * m) * D; bf16* xb = xb0 + ro;
                f32x4 b0, b1, b2, b3;
                if (BASE_F32) { b0 = pre[q % 4][0]; b1 = pre[q % 4][1]; b2 = pre[q % 4][2]; b3 = pre[q % 4][3]; }
                else { const u32x4 h0 = prh[q % 4][0], h1 = prh[q % 4][1];
                    b0 = (f32x4){bflo(h0.x), bfhi(h0.x), bflo(h0.y), bfhi(h0.y)}; b1 = (f32x4){bflo(h0.z), bfhi(h0.z), bflo(h0.w), bfhi(h0.w)};
                    b2 = (f32x4){bflo(h1.x), bfhi(h1.x), bflo(h1.y), bfhi(h1.y)}; b3 = (f32x4){bflo(h1.z), bfhi(h1.z), bflo(h1.w), bfhi(h1.w)}; }
                const f32x4 x0 = b0 + acc[ai][0][m][0], x1 = b1 + acc[ai][0][m][1], x2 = b2 + acc[ai][1][m][0], x3 = b3 + acc[ai][1][m][1];
                if (WRITE_Y) { float* o_ = op + ro; *(f32x4*)o_ = x0; *(f32x4*)(o_ + 4) = x1; *(f32x4*)(o_ + 128) = x2; *(f32x4*)(o_ + 132) = x3; }
                else { *(u32x4*)xb = pack8(x0, x1); *(u32x4*)(xb + 128) = pack8(x2, x3); }
                float s = (sq4(x0) + sq4(x1)) + (sq4(x2) + sq4(x3));
                s += __shfl_xor(s, 16); s += __shfl_xor(s, 32);
                if (fq == 0) scr[rl * 4 + wc] = s;
                asm volatile("" ::: "memory"); }
#undef G2_LOAD
        }
        EPI_BAR();
        if (!WRITE_Y && active && wc == 0 && fq == 0) {
#pragma unroll
            for (int ai = 0; ai < NAI; ++ai)
#pragma unroll
                for (int m = 0; m < 4; ++m) { const int rl = 128 * ai + rl0 + 16 * m; const f32x4 t4 = *(const f32x4*)(scr + rl * 4); ssq[(size_t)(row0 + rl) * 8 + pn] = (t4.x + t4.y) + (t4.z + t4.w); }
        }
    }
};

template <class Epi> __device__ __forceinline__ void skinny_unit(PG8_LAS unsigned char* lds, const bf16* A, const bf16* Bt, int K, const Epi& E, int row0, int pn) {
    using pg8::bf16x8; using pg8::f32x4;
    const int tid = fresh_tid(), wid = __builtin_amdgcn_readfirstlane(tid >> 6), lane = tid & 63, wr = wid >> 2, wc = wid & 3, fr = lane & 15, fq = lane >> 4;
    const int nt = K / 64;
    unsigned voffA, voffB[2];
    { int R, C; pg8::stage_rc(tid * 16, R, C); voffA = (unsigned)(R * K + C) * 2u; }
#pragma unroll
    for (int i = 0; i < 2; ++i) { int R, C; pg8::stage_rc(tid * 16 + i * 8192, R, C); const int Rb = (R & ~31) + pg8::perm32(R & 31); voffB[i] = (unsigned)(Rb * K + C) * 2u; }
    const char* gA = (const char*)(A + (size_t)row0 * K); const char* gB = (const char*)(Bt + (size_t)pn * 256 * K);
    const size_t hstep = (size_t)128 * K * 2; const unsigned ldsw = (unsigned)wid * 1024u;
    const int aoff = pg8::lds_byte(fr, fq * 8), boff = pg8::lds_byte(wc * 32 + fr, fq * 8);
    constexpr int STG = 40960;
#define SK_STAGE(s, kt) do { const size_t ko_ = (size_t)(kt) * 128; \
        __builtin_amdgcn_global_load_lds((const unsigned*)(gA + voffA + ko_), (PG8_LAS unsigned*)(lds + (s) * STG + ldsw), 16, 0, 0); \
        _Pragma("unroll") for (int h_ = 0; h_ < 2; ++h_) _Pragma("unroll") for (int i_ = 0; i_ < 2; ++i_) \
            __builtin_amdgcn_global_load_lds((const unsigned*)(gB + h_ * hstep + voffB[i_] + ko_), (PG8_LAS unsigned*)(lds + (s) * STG + 8192 + h_ * 16384 + ldsw + i_ * 8192), 16, 0, 0); } while (0)
    f32x4 acc[2][2][4][2];
#pragma unroll
    for (int a = 0; a < 2; ++a)
#pragma unroll
        for (int b = 0; b < 2; ++b)
#pragma unroll
            for (int m = 0; m < 4; ++m)
#pragma unroll
                for (int n = 0; n < 2; ++n) acc[a][b][m][n] = (f32x4){0.f, 0.f, 0.f, 0.f};
    SK_STAGE(0, 0); SK_STAGE(1, 1);
    int s = 0;
    for (int kt = 0; kt < nt; ++kt) {
        if (kt + 1 < nt) asm volatile("s_waitcnt vmcnt(5)" ::: "memory"); else asm volatile("s_waitcnt vmcnt(0)" ::: "memory");
        __builtin_amdgcn_s_barrier(); asm volatile("" ::: "memory");
        if (kt + 2 < nt) { const int s2 = s >= 1 ? s - 1 : 2; SK_STAGE(s2, kt + 2); }
        if (wr == 0) {
            bf16x8 At[4][2], B0[2][2], B1[2][2];
#pragma unroll
            for (int m = 0; m < 4; ++m)
#pragma unroll
                for (int k = 0; k < 2; ++k) At[m][k] = *(const PG8_LAS bf16x8*)(lds + s * STG + aoff + m * 2048 + k * 1024);
#pragma unroll
            for (int n = 0; n < 2; ++n)
#pragma unroll
                for (int k = 0; k < 2; ++k) { B0[n][k] = *(const PG8_LAS bf16x8*)(lds + s * STG + 8192 + boff + n * 2048 + k * 1024); B1[n][k] = *(const PG8_LAS bf16x8*)(lds + s * STG + 8192 + 16384 + boff + n * 2048 + k * 1024); }
#pragma unroll
            for (int m = 0; m < 4; ++m)
#pragma unroll
                for (int n = 0; n < 2; ++n)
#pragma unroll
                    for (int k = 0; k < 2; ++k) { acc[0][0][m][n] = __builtin_amdgcn_mfma_f32_16x16x32_bf16(B0[n][k], At[m][k], acc[0][0][m][n], 0, 0, 0);
                                                  acc[0][1][m][n] = __builtin_amdgcn_mfma_f32_16x16x32_bf16(B1[n][k], At[m][k], acc[0][1][m][n], 0, 0, 0); }
        }
        s = s == 2 ? 0 : s + 1;
    }
#undef SK_STAGE
    asm volatile("s_waitcnt lgkmcnt(0)" ::: "memory"); __builtin_amdgcn_s_barrier(); asm volatile("" ::: "memory");
    E.template run<1>(acc, row0, pn, wr, wc, fr, fq, wr == 0);
}
__device__ __forceinline__ void skinny_map(int unit, int ncol, int& ps, int& pn) {
    const int x = unit & 7, r = unit >> 3, per = ncol / 8;
    ps = r & 7; pn = x * per + (r >> 3);
}

__device__ __forceinline__ void ph_gemm1_attn(const Args& a, unsigned char* shm, int bid, int nblk, int layer) {
    const int j = layer >> 1;
    pg8::Gemm g{(const bf16*)(a.ws + WS_XB), (const bf16*)(a.ws + WS_WIN) + (size_t)layer * NP * D, MP, NP, D};
    pg8::StaticOrder S; S.init(MP, NP, nblk, bid);
    EpiG1Attn E{(const float*)(a.ws + WS_SSQ), (bf16*)(a.ws + WS_QB), (bf16*)(a.ws + WS_KB), (bf16*)(a.ws + WS_VB), (bf16*)(a.ws + WS_GB), a.out, a.in[8] + j * HD, a.in[9] + j * HD, (float*)(shm + EPI_OFF), j};
    if (threadIdx.x == 0) *(volatile LAS int*)((LAS unsigned char*)shm + RS_TAG_OFF) = -1;
    __syncthreads();
    pg8::gemm_phase<EpiG1Attn, pg8::StaticOrder, true, true>((LAS unsigned char*)shm, g, S, E);
    for (int unit = bid; unit < (MS / 64) * (NP / 256); unit += nblk) { int ps, pn; skinny_map(unit, NP / 256, ps, pn); skinny_unit((LAS unsigned char*)shm, g.A, g.Bt, D, E, MP + 64 * ps, pn); }
}
__device__ __forceinline__ void ph_gemm1_hgrn(const Args& a, unsigned char* shm, int bid, int nblk, int layer) {
    const int j = layer >> 1;
    pg8::Gemm g{(const bf16*)(a.ws + WS_XB), (const bf16*)(a.ws + WS_WIN) + (size_t)layer * NP * D, MP, NP, D};
    pg8::StaticOrder S; S.init(MP, NP, nblk, bid);
    EpiG1Hgrn E{(const float*)(a.ws + WS_SSQ), (bf16*)(a.ws + WS_QB), (unsigned short*)(a.ws + WS_LF), (bf16*)(a.ws + WS_VB), (bf16*)(a.ws + WS_GB), (const float*)(a.ws + WS_OML) + j * D, (float*)(shm + EPI_OFF), j == 0};
    if (threadIdx.x == 0) *(volatile LAS int*)((LAS unsigned char*)shm + RS_TAG_OFF) = -1;
    __syncthreads();
    pg8::gemm_phase<EpiG1Hgrn, pg8::StaticOrder, true, true>((LAS unsigned char*)shm, g, S, E);
    for (int unit = bid; unit < (MS / 64) * (NP / 256); unit += nblk) { int ps, pn; skinny_map(unit, NP / 256, ps, pn); skinny_unit((LAS unsigned char*)shm, g.A, g.Bt, D, E, MP + 64 * ps, pn); }
}
template <bool BASE_F32, bool WRITE_Y> __device__ __forceinline__ void gemm2_run(const Args& a, unsigned char* shm, int bid, int nblk, int layer) {
    pg8::Gemm g{(const bf16*)(a.ws + WS_OG), (const bf16*)(a.ws + WS_WOUT) + (size_t)layer * D * D, MP, D, D};
    pg8::StaticOrder S; S.init(MP, D, nblk, bid);
    EpiG2<BASE_F32, WRITE_Y> E{a.in[0], a.in[1], a.out, (bf16*)(a.ws + WS_XB), (float*)(a.ws + WS_SSQ), (float*)(shm + EPI_OFF)};
    pg8::gemm_phase<EpiG2<BASE_F32, WRITE_Y>, pg8::StaticOrder, true, true>((LAS unsigned char*)shm, g, S, E);
    constexpr int NSK = (MS / 64) * (D / 256);
    for (int unit = bid; unit < NSK; unit += nblk) { int ps, pn; skinny_map(unit, D / 256, ps, pn); skinny_unit((LAS unsigned char*)shm, g.A, g.Bt, D, E, MP + 64 * ps, pn); }
}
__device__ __forceinline__ void ph_gemm2(const Args& a, unsigned char* shm, int bid, int nblk, int layer) {
    if (layer == DEPTH - 1) gemm2_run<false, true>(a, shm, bid, nblk, layer);
    else gemm2_run<false, false>(a, shm, bid, nblk, layer);
    if (layer + 1 < DEPTH) {
        constexpr int NSK = (MS / 64) * (D / 256);
        const int tid = fresh_tid(), lane = tid & 63, wave = tid >> 6; unsigned char* scr = shm + wave * (64 * 132);
        if (nblk > NSK) { if (bid >= NSK) convert_layer_weights(a, scr, layer + 1, (bid - NSK) * 8 + wave, (nblk - NSK) * 8, lane); }
        else convert_layer_weights(a, scr, layer + 1, bid * 8 + wave, nblk * 8, lane);
    }
}

constexpr int CW_BAR = 4096;
static_assert((CW_BAR + XCD_BAR_WORDS) * 4 <= (int)CTL_BYTES, "CTL region");

__global__ void __launch_bounds__(512, 2) mega_fwd(Args a) {
    extern __shared__ __attribute__((aligned(16))) unsigned char shm[];
    const int tid = threadIdx.x, bid = blockIdx.x, nblk = gridDim.x;
    for (int u = tid; u < 256; u += 512) ((LAS unsigned*)((LAS unsigned char*)shm + LDSCTL_OFF))[u] = 0u;
    __syncthreads();
    XcdBarrier bar = xcd_barrier_post((unsigned*)(a.ws + WS_CTL) + CW_BAR, (volatile LAS unsigned*)((LAS unsigned char*)shm + LDSCTL_OFF + 32));
    prologue_phase(a, shm, bid, nblk);
    xcd_barrier(bar);
#define LAYER_ATTN(L) do { ph_gemm1_attn(a, shm, bid, nblk, (L)); xcd_barrier(bar); ph_attn(a, shm, bid, nblk, (L)); xcd_barrier(bar); ph_gemm2(a, shm, bid, nblk, (L)); xcd_barrier(bar); } while (0)
#define LAYER_HGRN(L) do { ph_gemm1_hgrn(a, shm, bid, nblk, (L)); xcd_barrier(bar); ph_hgrn1(a, shm, bid, nblk, (L)); xcd_barrier(bar); ph_hgrn2(a, shm, bid, nblk, (L)); xcd_barrier(bar); ph_gemm2(a, shm, bid, nblk, (L)); xcd_barrier(bar); } while (0)
    LAYER_ATTN(0); LAYER_HGRN(1); LAYER_ATTN(2); LAYER_HGRN(3);
#undef LAYER_ATTN
#undef LAYER_HGRN
}

extern "C" void kernel_launch(void* const* d_in, const int* in_sizes, int n_in, void* d_out, int out_size, void* d_ws, size_t ws_size, hipStream_t stream) {
    static int grid = 0;
    if (grid == 0) {
        if (n_in != 12 || (size_t)out_size != O_END || ws_size < WS_END) { fprintf(stderr, "kernel_launch: unexpected shapes n_in %d out %d ws %zu\n", n_in, out_size, ws_size); grid = -1; return; }
        int dev = 0, cus = 0, per_cu = 0;
        if (hipGetDevice(&dev) != hipSuccess || hipDeviceGetAttribute(&cus, hipDeviceAttributeMultiprocessorCount, dev) != hipSuccess) { fprintf(stderr, "kernel_launch: device query failed\n"); grid = -1; return; }
        if (hipFuncSetAttribute((const void*)mega_fwd, hipFuncAttributeMaxDynamicSharedMemorySize, LDS_BYTES) != hipSuccess) { fprintf(stderr, "kernel_launch: hipFuncSetAttribute failed\n"); grid = -1; return; }
        if (hipOccupancyMaxActiveBlocksPerMultiprocessor(&per_cu, (const void*)mega_fwd, 512, LDS_BYTES) != hipSuccess || per_cu < 1) { fprintf(stderr, "kernel_launch: occupancy query says %d blocks per CU\n", per_cu); (void)hipGetLastError(); grid = -1; return; }
        grid = cus;
    }
    if (grid < 0) return;
    if (hipMemsetAsync((char*)d_ws + WS_CTL, 0, CTL_BYTES, stream) != hipSuccess) { fprintf(stderr, "kernel_launch: memset failed\n"); return; }
    Args a; memset(&a, 0, sizeof(a));
    for (int i = 0; i < 12; ++i) a.in[i] = (const float*)d_in[i];
    a.out = (float*)d_out; a.ws = (unsigned char*)d_ws;
    hipLaunchKernelGGL(mega_fwd, dim3(grid), dim3(512), LDS_BYTES, stream, a);
    const hipError_t le = hipPeekAtLastError();
    if (le != hipSuccess) fprintf(stderr, "kernel_launch: launch failed: %s\n", hipGetErrorName(le));
}
```
